# Optimizing an MI355X kernel written in HIP

```python
import jax, jax.numpy as jnp
from jax import lax
import numpy as np

D_MODEL = 1024
BATCH = 32
SEQ = 2048
DEPTH = 1

GRID_W = 64
N_HEADS = 16
HEAD_DIM = D_MODEL // N_HEADS
ATTN_WIDTH = N_HEADS * HEAD_DIM
WIN_ROWS = 8
WIN_COLS = 16
Q_COLS = 16
K_COLS = 32
N_CBLK = GRID_W // Q_COLS
LRU_WIDTH = D_MODEL
LRU_BLOCKS = 16
LRU_BLOCK = LRU_WIDTH // LRU_BLOCKS
LRU_C = 8.0
CONV_W = 4
CONV_LEFT = 2
D_FF = 2816
FFN_RES = 0.5
EPS = 1e-6
IN_WIDTH = 2 * LRU_WIDTH + 3 * ATTN_WIDTH + 2 * D_MODEL

kernel_name = 'hybrid_rglru_natten_macaron_block'


def _rmsnorm(x, g):
    xf = x.astype(jnp.float32)
    y = xf * lax.rsqrt(jnp.mean(xf * xf, axis=-1, keepdims=True) + EPS)
    return (y * g.astype(jnp.float32)).astype(x.dtype)


def _swiglu(h, w_gu, w_down):
    g, u = jnp.split(h @ w_gu, 2, axis=-1)
    return (jax.nn.silu(g) * u) @ w_down


def _centred_dwconv(x, w, b):
    S = x.shape[1]
    xp = jnp.pad(x, ((0, 0), (CONV_LEFT, CONV_W - 1 - CONV_LEFT), (0, 0)))
    y = b
    for k in range(CONV_W):
        y = y + xp[:, k:k + S] * w[k]
    return y


def _lin_combine(left, right):
    a1, b1 = left
    a2, b2 = right
    return a1 * a2, a2 * b1 + b2


def _rglru_scan(xc, w_gates, b_gates, lam):
    B_, S, W = xc.shape
    xb = xc.reshape(B_, S, LRU_BLOCKS, LRU_BLOCK)
    gates = jnp.einsum('bsni,gnio->gbsno', xb, w_gates.astype(jnp.float32)).reshape(2, B_, S, W)
    gates = gates + b_gates.astype(jnp.float32)[:, None, None, :]
    r = jax.nn.sigmoid(gates[0])
    i = jax.nn.sigmoid(gates[1])
    log_a = -LRU_C * r * jax.nn.softplus(-lam.astype(jnp.float32))
    a = jnp.exp(log_a)
    bx = jnp.sqrt(-jnp.expm1(2.0 * log_a)) * (i * xc)
    _, h = lax.associative_scan(_lin_combine, (a, bx), axis=1)
    return h


def _col_tables():
    qc = np.arange(GRID_W).reshape(N_CBLK, Q_COLS)
    kstart = np.clip(np.arange(N_CBLK) * Q_COLS - WIN_COLS // 2, 0, GRID_W - K_COLS)
    kc = kstart[:, None] + np.arange(K_COLS)[None, :]
    cs = np.clip(qc - WIN_COLS // 2, 0, GRID_W - WIN_COLS)
    valid = (kc[:, None, :] >= cs[:, :, None]) & (kc[:, None, :] < cs[:, :, None] + WIN_COLS)
    dc = np.clip(kc[:, None, :] - qc[:, :, None], -(WIN_COLS - 1), WIN_COLS - 1) + WIN_COLS - 1
    return kc, valid, dc


def _neighbourhood_attention(q, k, v, rpb):
    B_, S, H, Dh = q.shape
    rows = S // GRID_W
    kr = min(WIN_ROWS, rows)
    kc, valid, dc = _col_tables()
    kg = k.reshape(B_, rows, GRID_W, H, Dh)[:, :, kc]
    vg = v.reshape(B_, rows, GRID_W, H, Dh)[:, :, kc]
    qg = jnp.moveaxis(q.reshape(B_, rows, N_CBLK, Q_COLS, H, Dh), 1, 0)
    rpb32 = rpb.astype(jnp.float32)
    mask = valid[None, None, :, :, None, :]

    def row_block(args):
        r, q_r = args
        rs = jnp.clip(r - kr // 2, 0, rows - kr)
        k_r = lax.dynamic_slice_in_dim(kg, rs, kr, axis=1)
        v_r = lax.dynamic_slice_in_dim(vg, rs, kr, axis=1)
        s = jnp.einsum('bnqhd,brnkhd->bhnqrk', q_r, k_r, preferred_element_type=jnp.float32)
        dr = rs + jnp.arange(kr) - r + WIN_ROWS - 1
        bias = rpb32[:, dr][:, :, dc]
        s = s + jnp.transpose(bias, (0, 2, 3, 1, 4))[None]
        s = jnp.where(mask, s, -jnp.inf)
        shp = s.shape
        p = jax.nn.softmax(s.reshape(shp[:4] + (kr * K_COLS,)), axis=-1).reshape(shp)
        return jnp.einsum('bhnqrk,brnkhd->bnqhd', p.astype(v.dtype), v_r)

    o = lax.map(row_block, (jnp.arange(rows), qg))
    return jnp.moveaxis(o, 0, 1).reshape(B_, S, H * Dh)


def setup_inputs(seed: int = 0) -> dict:
    key = jax.random.key(seed)
    ks = jax.random.split(key, 20)
    f32 = jnp.float32
    nrm = lambda k, shape, s: jax.random.normal(k, shape, f32) * s
    u = jax.random.uniform(ks[10], (DEPTH, 2, LRU_WIDTH), f32, minval=0.9, maxval=0.999)
    sg = u ** (1.0 / LRU_C)
    lru_lambda = jnp.log(sg) - jnp.log1p(-sg)
    return {
        'x': jax.random.normal(ks[0], (BATCH, SEQ, D_MODEL), f32),
        'norm_ffn1': 1.0 + nrm(ks[1], (DEPTH, D_MODEL), 0.02),
        'w_ffn1_gu': nrm(ks[2], (DEPTH, D_MODEL, 2 * D_FF), D_MODEL ** -0.5),
        'w_ffn1_down': nrm(ks[3], (DEPTH, D_FF, D_MODEL), D_FF ** -0.5),
        'norm_mix': 1.0 + nrm(ks[4], (DEPTH, D_MODEL), 0.02),
        'w_in': nrm(ks[5], (DEPTH, D_MODEL, IN_WIDTH), D_MODEL ** -0.5),
        'conv_w': nrm(ks[6], (DEPTH, CONV_W, LRU_WIDTH), CONV_W ** -0.5),
        'conv_b': nrm(ks[7], (DEPTH, LRU_WIDTH), 0.01),
        'lru_w_gates': nrm(ks[8], (DEPTH, 2, 2, LRU_BLOCKS, LRU_BLOCK, LRU_BLOCK), LRU_BLOCK ** -0.5),
        'lru_b_gates': nrm(ks[9], (DEPTH, 2, 2, LRU_WIDTH), 0.1),
        'lru_lambda': lru_lambda,
        'q_norm': 1.0 + nrm(ks[11], (DEPTH, HEAD_DIM), 0.02),
        'k_norm': 1.0 + nrm(ks[12], (DEPTH, HEAD_DIM), 0.02),
        'rel_pos_bias': nrm(ks[13], (DEPTH, N_HEADS, 2 * WIN_ROWS - 1, 2 * WIN_COLS - 1), 0.1),
        'w_out': nrm(ks[14], (DEPTH, D_MODEL, D_MODEL), D_MODEL ** -0.5),
        'norm_ffn2': 1.0 + nrm(ks[15], (DEPTH, D_MODEL), 0.02),
        'w_ffn2_gu': nrm(ks[16], (DEPTH, D_MODEL, 2 * D_FF), D_MODEL ** -0.5),
        'w_ffn2_down': nrm(ks[17], (DEPTH, D_FF, D_MODEL), D_FF ** -0.5),
    }


def reference(x, norm_ffn1, w_ffn1_gu, w_ffn1_down, norm_mix, w_in, conv_w, conv_b,
              lru_w_gates, lru_b_gates, lru_lambda, q_norm, k_norm, rel_pos_bias, w_out,
              norm_ffn2, w_ffn2_gu, w_ffn2_down):
    B_, S, _ = x.shape
    splits = list(np.cumsum([LRU_WIDTH, LRU_WIDTH, ATTN_WIDTH, ATTN_WIDTH, ATTN_WIDTH, D_MODEL]))
    for l in range(DEPTH):
        x = x + FFN_RES * _swiglu(_rmsnorm(x, norm_ffn1[l]), w_ffn1_gu[l], w_ffn1_down[l])

        h = _rmsnorm(x, norm_mix[l])
        xr, gr, q, k, v, ga, gb = jnp.split(h @ w_in[l], splits, axis=-1)

        xc = _centred_dwconv(xr, conv_w[l], conv_b[l]).astype(jnp.float32)
        h_fwd = _rglru_scan(xc, lru_w_gates[l, 0], lru_b_gates[l, 0], lru_lambda[l, 0])
        h_bwd = jnp.flip(_rglru_scan(jnp.flip(xc, 1), lru_w_gates[l, 1], lru_b_gates[l, 1],
                                     lru_lambda[l, 1]), 1)
        y_lru = ((h_fwd + h_bwd) * jax.nn.gelu(gr.astype(jnp.float32))).astype(x.dtype)

        q = _rmsnorm(q.reshape(B_, S, N_HEADS, HEAD_DIM), q_norm[l]) * (HEAD_DIM ** -0.5)
        k = _rmsnorm(k.reshape(B_, S, N_HEADS, HEAD_DIM), k_norm[l])
        v = v.reshape(B_, S, N_HEADS, HEAD_DIM)
        y_att = _neighbourhood_attention(q, k, v, rel_pos_bias[l]).astype(x.dtype)

        y = jax.nn.sigmoid(ga) * y_lru + jax.nn.sigmoid(gb) * y_att
        x = x + y @ w_out[l]

        x = x + FFN_RES * _swiglu(_rmsnorm(x, norm_ffn2[l]), w_ffn2_gu[l], w_ffn2_down[l])
    return x
```

```cpp
#include <hip/hip_runtime.h>
#include <hip/hip_cooperative_groups.h>
#include <cstdio>
#include <cstdint>
namespace cg = cooperative_groups;
namespace pg8 {
#define PG8_LAS __attribute__((address_space(3)))
typedef unsigned short bf16_t;
typedef short bf16x8 __attribute__((ext_vector_type(8)));
typedef float f32x4 __attribute__((ext_vector_type(4)));
typedef unsigned u32x4 __attribute__((ext_vector_type(4)));
constexpr int BM = 256, BK = 64, HALF = 128, HTB = HALF * BK * 2  , STAGE_BYTES = 8 * HTB, NXCD = 8, WGM = 8;

__host__ __device__ __forceinline__ int lds_byte(int r, int c) { const int st = (r >> 4) * 2 + (c >> 5), rr = r & 15, cc = c & 31, ob = rr * 64 + cc * 2; return st * 1024 + (ob ^ (((ob >> 9) & 1) << 5)); }
__host__ __device__ __forceinline__ void stage_rc(int b, int& R, int& C) { const int st = b / 1024, sb = b % 1024, swz = sb ^ (((sb >> 9) & 1) << 5); R = (st >> 1) * 16 + swz / 64; C = (st & 1) * 32 + (swz % 64) / 2; }
__host__ __device__ __forceinline__ int perm32(int rho) { const int n = rho >> 4, i = rho & 15; return 8 * (i >> 2) + 4 * n + (i & 3); }

struct Unit { int pm, pn; };
struct Gemm { const bf16_t* A; const bf16_t* Bt; int M, N, K; };

struct StaticOrder {
    int nM, nN, nwg, G, c; bool rev = false;
    __host__ __device__ void init(int M, int N, int G_, int c_) { nM = M / BM; nN = N / BM; nwg = nM * nN; G = G_; c = c_; }
    __host__ __device__ bool next(int i, Unit& u) const {
        const long L = (long)i * G + c; if (L >= nwg) return false;
        int wgid = (int)L; { const int q = nwg / NXCD, r = nwg % NXCD, xcd = wgid % NXCD, off = wgid / NXCD; wgid = (xcd < r ? xcd * (q + 1) : r * (q + 1) + (xcd - r) * q) + off; }
        const int nig = WGM * nN, gid = wgid / nig, fm = gid * WGM, gsz = (nM - fm) < WGM ? (nM - fm) : WGM;
        u.pm = fm + ((wgid % nig) % gsz); u.pn = (wgid % nig) / gsz; if (rev) u.pm = nM - 1 - u.pm; return true;
    }
    __device__ __forceinline__ void a_ready(const Unit&) const {}
    __device__ __forceinline__ void done(const Unit&) const {}
};

typedef float f32x2_cv __attribute__((ext_vector_type(2))); typedef __bf16 bf16x2_cv __attribute__((ext_vector_type(2)));
__device__ __forceinline__ unsigned cvt_pk_bf16(float lo, float hi) { f32x2_cv v = {lo, hi}; bf16x2_cv b = __builtin_convertvector(v, bf16x2_cv); return __builtin_bit_cast(unsigned, b); }
template <class Epi, class Sched, bool ALIGN_EPI = false, bool SP2 = false>
__device__ __forceinline__ void gemm_phase(PG8_LAS unsigned char* lds, const Gemm g, const Sched& S, const Epi& E) {
    const int tid = threadIdx.x, wid = __builtin_amdgcn_readfirstlane(tid >> 6), lane = tid & 63, wr = wid >> 2, wc = wid & 3, fr = lane & 15, fq = lane >> 4;
    const int K = g.K, nt = K / BK;
    unsigned voffA[2], voffB[2];
#pragma unroll
    for (int i = 0; i < 2; ++i) { int R, C; stage_rc(tid * 16 + i * 8192, R, C); const int Rb = Epi::PERM ? ((R & ~31) + perm32(R & 31)) : R;
        voffA[i] = (unsigned)(R * K + C) * 2u; voffB[i] = (unsigned)(Rb * K + C) * 2u; }
    const size_t kstep = (size_t)(BK * 2);
    const size_t hstep = (size_t)HALF * K * 2;
    const size_t tstep = 2 * hstep;
    const unsigned ldsw = (unsigned)wid * 1024u;
    const int aoff = lds_byte(wr * 64 + fr, fq * 8), boff = lds_byte(wc * 32 + fr, fq * 8);
#define PG8_SA(b, h) (((b) * 2 + (h)) * HTB)
#define PG8_SB(b, h) ((4 + (b) * 2 + (h)) * HTB)
#define PG8_STAGE(bufoff, gbase, voff) do { _Pragma("unroll") for (int _i = 0; _i < 2; ++_i) \
        __builtin_amdgcn_global_load_lds((const unsigned*)((const char*)(gbase) + (voff)[_i]), (PG8_LAS unsigned*)(lds + (bufoff) + ldsw + _i * 8192), 16, 0, 0); } while (0)
#define PG8_LDA(dst, b, h) do { _Pragma("unroll") for (int m = 0; m < 4; ++m) _Pragma("unroll") for (int k = 0; k < 2; ++k) dst[m][k] = *(const PG8_LAS bf16x8*)(lds + PG8_SA(b, h) + aoff + m * 2048 + k * 1024); } while (0)
#define PG8_LDB(dst, b, h) do { _Pragma("unroll") for (int n = 0; n < 2; ++n) _Pragma("unroll") for (int k = 0; k < 2; ++k) dst[n][k] = *(const PG8_LAS bf16x8*)(lds + PG8_SB(b, h) + boff + n * 2048 + k * 1024); } while (0)
#define PG8_MMA(ai, bj, At, Bt) do { __builtin_amdgcn_s_setprio(1); _Pragma("unroll") for (int m = 0; m < 4; ++m) _Pragma("unroll") for (int n = 0; n < 2; ++n) _Pragma("unroll") for (int k = 0; k < 2; ++k) \
        acc[ai][bj][m][n] = __builtin_amdgcn_mfma_f32_16x16x32_bf16(Bt[n][k], At[m][k], acc[ai][bj][m][n], 0, 0, 0); __builtin_amdgcn_s_setprio(0); } while (0)
#define PG8_WAIT_V(n) asm volatile("s_waitcnt vmcnt(" #n ")" ::: "memory")
#define PG8_WAIT_L(n) asm volatile("s_waitcnt lgkmcnt(" #n ")" ::: "memory")
#define PG8_BAR __builtin_amdgcn_s_barrier()
#define PG8_SCHED __builtin_amdgcn_sched_barrier(0)
    Unit cur, nxt; int ui = 0;
    float epi_pre[8];
#pragma unroll
    for (int i = 0; i < 8; ++i) epi_pre[i] = 0.f;
    if (!S.next(0, cur)) return;
    f32x4 acc[2][2][4][2];
#pragma unroll
    for (int a = 0; a < 2; ++a)
#pragma unroll
        for (int b = 0; b < 2; ++b)
#pragma unroll
            for (int m = 0; m < 4; ++m)
#pragma unroll
                for (int n = 0; n < 2; ++n) acc[a][b][m][n] = (f32x4){0.f, 0.f, 0.f, 0.f};
    bf16x8 At[4][2], B0[2][2], B1[2][2];
    const char* cA = (const char*)g.A + (size_t)cur.pm * tstep; const char* cB = (const char*)g.Bt + (size_t)cur.pn * tstep;
    S.a_ready(cur);
    if constexpr (SP2) {
        PG8_STAGE(PG8_SB(0, 0), cB, voffB); PG8_STAGE(PG8_SB(0, 1), cB + hstep, voffB); PG8_STAGE(PG8_SA(0, 0), cA, voffA); PG8_STAGE(PG8_SA(0, 1), cA + hstep, voffA);
        if (wr == 1) PG8_BAR;
        PG8_WAIT_V(2); PG8_BAR;
        PG8_STAGE(PG8_SB(1, 0), cB + kstep, voffB); PG8_STAGE(PG8_SA(1, 0), cA + kstep, voffA); PG8_STAGE(PG8_SB(1, 1), cB + hstep + kstep, voffB);
        PG8_WAIT_V(6); PG8_BAR;
    } else {
        PG8_STAGE(PG8_SB(0, 0), cB, voffB); PG8_STAGE(PG8_SA(0, 0), cA, voffA); PG8_STAGE(PG8_SB(0, 1), cB + hstep, voffB); PG8_STAGE(PG8_SA(0, 1), cA + hstep, voffA);
        if (wr == 1) PG8_BAR;
        PG8_WAIT_V(4); PG8_BAR;
        PG8_STAGE(PG8_SB(1, 0), cB + kstep, voffB); PG8_STAGE(PG8_SA(1, 0), cA + kstep, voffA); PG8_STAGE(PG8_SB(1, 1), cB + hstep + kstep, voffB);
        PG8_WAIT_V(6); PG8_BAR;
    }
    for (;;) {
        const bool has_next = S.next(ui + 1, nxt);
        const char* nA = has_next ? (const char*)g.A + (size_t)nxt.pm * tstep : cA; const char* nB = has_next ? (const char*)g.Bt + (size_t)nxt.pn * tstep : cB;
        for (int t = 0; t < nt; t += 2) {
            const bool last = (t == nt - 2);
            if (last) E.prefetch(epi_pre, cur, wr, fr);
            const char* a1 = cA + (size_t)(t + 1) * kstep;
            const char* a2 = last ? nA : cA + (size_t)(t + 2) * kstep; const char* b2 = last ? nB : cB + (size_t)(t + 2) * kstep;
            const char* a3 = a2 + kstep; const char* b3 = b2 + kstep;
            if (last && has_next) S.a_ready(nxt);
            if constexpr (SP2) {
            PG8_LDB(B0, 0, 0); PG8_LDB(B1, 0, 1); PG8_SCHED; PG8_LDA(At, 0, 0); PG8_STAGE(PG8_SA(1, 1), a1 + hstep, voffA);
            PG8_WAIT_V(8); PG8_WAIT_L(0); PG8_BAR; PG8_MMA(0, 0, At, B0); PG8_MMA(0, 1, At, B1); PG8_BAR; PG8_SCHED;
            PG8_LDA(At, 0, 1); PG8_STAGE(PG8_SB(0, 0), b2, voffB); PG8_STAGE(PG8_SB(0, 1), b2 + hstep, voffB); PG8_STAGE(PG8_SA(0, 0), a2, voffA);
            PG8_WAIT_V(8); PG8_WAIT_L(0); PG8_BAR; PG8_MMA(1, 0, At, B0); PG8_MMA(1, 1, At, B1); PG8_BAR; PG8_SCHED;
            PG8_LDB(B0, 1, 0); PG8_LDB(B1, 1, 1); PG8_SCHED; PG8_LDA(At, 1, 0); PG8_STAGE(PG8_SA(0, 1), a2 + hstep, voffA);
            PG8_WAIT_V(8); PG8_WAIT_L(0); PG8_BAR; PG8_MMA(0, 0, At, B0); PG8_MMA(0, 1, At, B1); PG8_BAR; PG8_SCHED;
            PG8_LDA(At, 1, 1); PG8_STAGE(PG8_SB(1, 0), b3, voffB); PG8_STAGE(PG8_SB(1, 1), b3 + hstep, voffB); PG8_STAGE(PG8_SA(1, 0), a3, voffA);
            PG8_WAIT_V(8); PG8_WAIT_L(0); PG8_BAR; PG8_MMA(1, 0, At, B0); PG8_MMA(1, 1, At, B1); PG8_BAR; PG8_SCHED;
            } else {
            PG8_LDB(B0, 0, 0); PG8_SCHED; PG8_LDA(At, 0, 0); PG8_STAGE(PG8_SA(1, 1), a1 + hstep, voffA);
            PG8_WAIT_L(8); PG8_BAR; PG8_WAIT_L(0); PG8_MMA(0, 0, At, B0); PG8_BAR; PG8_SCHED;
            PG8_LDB(B1, 0, 1); PG8_STAGE(PG8_SB(0, 0), b2, voffB);
            PG8_BAR; PG8_WAIT_L(0); PG8_MMA(0, 1, At, B1); PG8_BAR;
            PG8_LDA(At, 0, 1); PG8_STAGE(PG8_SA(0, 0), a2, voffA);
            PG8_BAR; PG8_WAIT_L(0); PG8_MMA(1, 0, At, B0); PG8_BAR; PG8_SCHED;
            PG8_STAGE(PG8_SB(0, 1), b2 + hstep, voffB);
            PG8_WAIT_V(6); PG8_BAR; PG8_MMA(1, 1, At, B1); PG8_BAR;
            PG8_LDB(B0, 1, 0); PG8_SCHED; PG8_LDA(At, 1, 0); PG8_STAGE(PG8_SA(0, 1), a2 + hstep, voffA);
            PG8_WAIT_L(8); PG8_BAR; PG8_WAIT_L(0); PG8_MMA(0, 0, At, B0); PG8_BAR; PG8_SCHED;
            PG8_LDB(B1, 1, 1); PG8_STAGE(PG8_SB(1, 0), b3, voffB);
            PG8_BAR; PG8_WAIT_L(0); PG8_MMA(0, 1, At, B1); PG8_BAR;
            PG8_LDA(At, 1, 1); PG8_STAGE(PG8_SA(1, 0), a3, voffA);
            PG8_BAR; PG8_WAIT_L(0); PG8_MMA(1, 0, At, B0); PG8_BAR; PG8_SCHED;
            PG8_STAGE(PG8_SB(1, 1), b3 + hstep, voffB);
            PG8_WAIT_V(6); PG8_BAR; PG8_MMA(1, 1, At, B1); PG8_BAR;
            }
        }
        if constexpr (ALIGN_EPI) { if (wr == 0) PG8_BAR; }
        if constexpr (!Epi::AFTER_DRAIN) { E(acc, cur, wr, wc, fr, fq, epi_pre); S.done(cur); }
        if (!has_next) break;
#pragma unroll
        for (int a = 0; a < 2; ++a)
#pragma unroll
            for (int b = 0; b < 2; ++b)
#pragma unroll
                for (int m = 0; m < 4; ++m)
#pragma unroll
                    for (int n = 0; n < 2; ++n) acc[a][b][m][n] = (f32x4){0.f, 0.f, 0.f, 0.f};
        cur = nxt; cA = nA; cB = nB; ++ui;
        if constexpr (ALIGN_EPI) { if (wr == 1) PG8_BAR; }
    }
    PG8_WAIT_V(0);
    if constexpr (!ALIGN_EPI) { if (wr == 0) PG8_BAR; }
    PG8_BAR;
    if constexpr (Epi::AFTER_DRAIN) { E.fused(acc, cur, wr, wc, fr, fq, lds, wid, lane); S.done(cur); }
#undef PG8_SA
#undef PG8_SB
#undef PG8_STAGE
#undef PG8_LDA
#undef PG8_LDB
#undef PG8_MMA
#undef PG8_WAIT_V
#undef PG8_WAIT_L
#undef PG8_BAR
#undef PG8_SCHED
}
}

#ifndef PG8_SP2
#define PG8_SP2 true
#endif
#ifndef PG8_ALIGN
#define PG8_ALIGN true
#endif
#ifndef MK_MULTI
#define MK_MULTI 0
#endif

constexpr int NWAVES = 8;
constexpr int BATCH = 32, SEQ = 2048, D = 1024, FF = 2816, NIN = 7168, NGU = 2 * FF;
constexpr int M = BATCH * SEQ;
constexpr int NH = 16, HD = 64, GW = 64, ROWS = SEQ / GW;
constexpr float EPS = 1e-6f;
constexpr float LOG2E = 1.4426950408889634f;

constexpr size_t MiB = 1u << 20;
constexpr size_t WS_SS0 = 0, WS_SS1 = 256 * 1024, WS_SS2 = 512 * 1024;
constexpr size_t WS_BAR = 768 * 1024;
constexpr size_t WS_WGU1 = 1 * MiB;
constexpr size_t WS_WDN1 = WS_WGU1 + (size_t)NGU * D * 2;
constexpr size_t WS_WIN  = WS_WDN1 + (size_t)D * FF * 2;
constexpr size_t WS_WOUT = WS_WIN + (size_t)NIN * D * 2;
constexpr size_t WS_WGU2 = WS_WOUT + (size_t)D * D * 2;
constexpr size_t WS_WDN2 = WS_WGU2 + (size_t)NGU * D * 2;
constexpr size_t WS_WG   = WS_WDN2 + (size_t)D * FF * 2;
constexpr size_t WS_HB   = 52 * MiB;
constexpr size_t ACT1    = (size_t)M * D * 2;
constexpr size_t WS_XR   = 180 * MiB;
constexpr size_t WS_GL   = WS_XR + ACT1, WS_Q = WS_GL + ACT1, WS_K = WS_Q + ACT1, WS_V = WS_K + ACT1, WS_GB = WS_V + ACT1;
constexpr size_t WS_ACT  = WS_XR;
constexpr size_t WS_END  = WS_GB + ACT1;
static_assert(WS_WG + 524288 <= WS_HB && WS_HB + ACT1 <= WS_XR && (size_t)M * FF * 2 <= 3 * ACT1, "d_ws map");

constexpr int LDS_BYTES = 147456;

#define LAS __attribute__((address_space(3)))
typedef unsigned short bf16;
typedef short bf16x8 __attribute__((ext_vector_type(8)));
typedef float f32x4 __attribute__((ext_vector_type(4)));
typedef unsigned u32x4 __attribute__((ext_vector_type(4)));
typedef unsigned u32x2 __attribute__((ext_vector_type(2)));

__device__ __forceinline__ float bf_lo(unsigned w) { return __uint_as_float(w << 16); }
__device__ __forceinline__ float bf_hi(unsigned w) { return __uint_as_float(w & 0xffff0000u); }
__device__ __forceinline__ unsigned pk2(float lo, float hi) { return pg8::cvt_pk_bf16(lo, hi); }
__device__ __forceinline__ float fexp2(float x) { return __builtin_amdgcn_exp2f(x); }
__device__ __forceinline__ float frcp(float x) { return __builtin_amdgcn_rcpf(x); }
__device__ __forceinline__ float sigm(float x) { return frcp(1.0f + fexp2(-x * LOG2E)); }
__device__ __forceinline__ float silu_f(float x) { return x * sigm(x); }
__device__ __forceinline__ float gelu_tanh(float x) {
    const float u2 = 1.5957691216057308f * (x + 0.044715f * x * x * x);
    return x * sigm(u2);
}
__device__ __forceinline__ float wave_sum(float v) {
#pragma unroll
    for (int o = 1; o < 64; o <<= 1) v += __shfl_xor(v, o);
    return v;
}

#define XB_TMO      128
#define XB_XCNT(j)  (256  + 64 * (j))
#define XB_XSUB(j)  (1280 + 64 * (j))
#define XB_XGEN(j)  (2304 + 64 * (j))
#define XB_TOP      3328
#define XB_TOPGEN   3392
#define XCD_BAR_WORDS 3456
#define XB_SPIN_CAP (1u << 18)

__device__ __forceinline__ unsigned xb_ld(unsigned* p)              { return __hip_atomic_load(p, __ATOMIC_RELAXED, __HIP_MEMORY_SCOPE_AGENT); }
__device__ __forceinline__ unsigned xb_add(unsigned* p, unsigned v) { return __hip_atomic_fetch_add(p, v, __ATOMIC_RELAXED, __HIP_MEMORY_SCOPE_AGENT); }
__device__ __forceinline__ unsigned xb_xcc_id() { return (unsigned)__builtin_amdgcn_s_getreg((3 << 11) | 20) & 0xFu; }
#define XB_SPIN(cond, bar) do { unsigned _sp = 0; while (cond) { __builtin_amdgcn_s_sleep(1); \
    if ((++_sp & 255u) == 0u) { if (xb_ld(&(bar)[XB_TMO])) break; if (_sp > XB_SPIN_CAP) { atomicAdd(&(bar)[XB_TMO], 1u); break; } } } } while (0)

struct XcdBarrier {
    unsigned* bar; unsigned x;
    volatile LAS unsigned* st;
};

__device__ __forceinline__ XcdBarrier xcd_barrier_post(unsigned* bar, volatile LAS unsigned* st) {
    XcdBarrier b; b.bar = bar; b.x = xb_xcc_id(); b.st = st;
    if (threadIdx.x == 0) (void)xb_add(&bar[XB_XCNT(b.x)], 1u);
    return b;
}
__device__ __forceinline__ void xcd_barrier_complete(unsigned* bar, unsigned x, unsigned& nloc, unsigned& nx) {
    const unsigned G = gridDim.x * gridDim.y * gridDim.z;
    unsigned sum, cnt, mine, sp = 0u;
    for (;;) {
        sum = 0u; cnt = 0u; mine = 0u;
#pragma unroll
        for (unsigned j = 0; j < 16; ++j) { const unsigned c = xb_ld(&bar[XB_XCNT(j)]); sum += c; cnt += (c > 0u) ? 1u : 0u; mine = (j == x) ? c : mine; }
        if (sum == G) break;
        __builtin_amdgcn_s_sleep(1);
        if ((++sp & 255u) == 0u) { if (xb_ld(&bar[XB_TMO])) break; if (sp > XB_SPIN_CAP) { atomicAdd(&bar[XB_TMO], 1u); break; } }
    }
    nloc = mine > 0u ? mine : 1u; nx = cnt > 0u ? cnt : 1u;
}

__device__ __forceinline__ void xcd_barrier(const XcdBarrier& b) {
    asm volatile("s_waitcnt vmcnt(0)" ::: "memory");
    __syncthreads();
    if (threadIdx.x == 0) {
        unsigned* bar = b.bar;
        __builtin_amdgcn_s_waitcnt(0);
        unsigned nloc = b.st[0], nx = b.st[1];
        if (nloc == 0u) { xcd_barrier_complete(bar, b.x, nloc, nx); b.st[0] = nloc; b.st[1] = nx; }
        const unsigned old = xb_add(&bar[XB_XSUB(b.x)], 1u);
        const unsigned gen = old / nloc;
        if (old + 1u == (gen + 1u) * nloc) {
            __builtin_amdgcn_fence(__ATOMIC_RELEASE, "agent");
            asm volatile("s_waitcnt vmcnt(0)" ::: "memory");
            const unsigned og = xb_add(&bar[XB_TOP], 1u);
            const unsigned tg = og / nx;
            if (og + 1u == (tg + 1u) * nx) xb_add(&bar[XB_TOPGEN], 1u);
            else XB_SPIN(xb_ld(&bar[XB_TOPGEN]) == tg, bar);
            __builtin_amdgcn_fence(__ATOMIC_ACQUIRE, "agent");
            xb_add(&bar[XB_XGEN(b.x)], 1u);
            asm volatile("s_waitcnt vmcnt(0)" ::: "memory");
        } else {
            XB_SPIN(xb_ld(&bar[XB_XGEN(b.x)]) == gen, bar);
            __builtin_amdgcn_fence(__ATOMIC_ACQUIRE, "agent");
            asm volatile("s_waitcnt vmcnt(0)" ::: "memory");
        }
    }
    __syncthreads();
}

namespace pg8 {
struct EpiGU {
    static constexpr bool PERM = true, AFTER_DRAIN = false;
    bf16_t* O; const float* SS;
    __device__ __forceinline__ void prefetch(float (&pre)[8], const Unit& u, int wr, int fr) const {
        const int row0 = u.pm * BM + wr * 64 + fr;
#pragma unroll
        for (int i = 0; i < 8; ++i) pre[i] = SS[row0 + (i >> 2) * HALF + (i & 3) * 16];
    }
    __device__ __forceinline__ void operator()(const f32x4 (&acc)[2][2][4][2], const Unit& u, int wr, int wc, int fr, int fq, const float (&pre)[8]) const {
        const int row0 = u.pm * BM + wr * 64 + fr, col0 = u.pn * 128 + wc * 32 + 8 * fq;
#pragma unroll
        for (int ai = 0; ai < 2; ++ai)
#pragma unroll
            for (int m = 0; m < 4; ++m) {
                const int row = row0 + ai * HALF + m * 16;
                const float rs = __builtin_amdgcn_rsqf(pre[ai * 4 + m] * (1.0f / D) + EPS);
                bf16_t* p = O + (size_t)row * FF + col0;
                const f32x4 g0 = acc[ai][0][m][0] * rs, g1 = acc[ai][0][m][1] * rs, u0 = acc[ai][1][m][0] * rs, u1 = acc[ai][1][m][1] * rs;
                u32x4 w;
                w.x = cvt_pk_bf16(silu_f(g0[0]) * u0[0], silu_f(g0[1]) * u0[1]); w.y = cvt_pk_bf16(silu_f(g0[2]) * u0[2], silu_f(g0[3]) * u0[3]);
                w.z = cvt_pk_bf16(silu_f(g1[0]) * u1[0], silu_f(g1[1]) * u1[1]); w.w = cvt_pk_bf16(silu_f(g1[2]) * u1[2], silu_f(g1[3]) * u1[3]);
                *(u32x4*)p = w;
            }
    }
};
template <bool LAST, bool HALFSCALE> struct EpiRes {
    static constexpr bool PERM = true, AFTER_DRAIN = false;
    bf16_t* XB; float* OUT; float* SS;
    static constexpr float scale = HALFSCALE ? 0.5f : 1.0f;
    __device__ __forceinline__ void prefetch(float (&)[8], const Unit&, int, int) const {}
    __device__ __forceinline__ void operator()(const f32x4 (&acc)[2][2][4][2], const Unit& u, int wr, int wc, int fr, int fq, const float (&)[8]) const {
        const int row0 = u.pm * BM + wr * 64 + fr, col0 = u.pn * BM + wc * 32 + 8 * fq;
#pragma unroll
        for (int ai = 0; ai < 2; ++ai) {
            u32x4 bs[4][2];
#pragma unroll
            for (int m = 0; m < 4; ++m) { const size_t off = (size_t)(row0 + ai * HALF + m * 16) * D + col0;
#pragma unroll
                for (int bj = 0; bj < 2; ++bj) bs[m][bj] = *(const u32x4*)(XB + off + bj * HALF); }
#pragma unroll
            for (int m = 0; m < 4; ++m) {
                const int row = row0 + ai * HALF + m * 16;
                const size_t off = (size_t)row * D + col0;
                float ss = 0.f;
#pragma unroll
                for (int bj = 0; bj < 2; ++bj) {
                    const u32x4 b = bs[m][bj];
                    const f32x4 b0 = {__uint_as_float(b.x << 16), __uint_as_float(b.x & 0xffff0000u), __uint_as_float(b.y << 16), __uint_as_float(b.y & 0xffff0000u)};
                    const f32x4 b1 = {__uint_as_float(b.z << 16), __uint_as_float(b.z & 0xffff0000u), __uint_as_float(b.w << 16), __uint_as_float(b.w & 0xffff0000u)};
                    const f32x4 v0 = b0 + acc[ai][bj][m][0] * scale, v1 = b1 + acc[ai][bj][m][1] * scale;
                    if (LAST) { *(f32x4*)(OUT + off + bj * HALF) = v0; *(f32x4*)(OUT + off + bj * HALF + 4) = v1; }
                    else {
                        u32x4 w; w.x = cvt_pk_bf16(v0[0], v0[1]); w.y = cvt_pk_bf16(v0[2], v0[3]); w.z = cvt_pk_bf16(v1[0], v1[1]); w.w = cvt_pk_bf16(v1[2], v1[3]);
                        *(u32x4*)(XB + off + bj * HALF) = w;
                        ss += (v0[0] * v0[0] + v0[1] * v0[1]) + (v0[2] * v0[2] + v0[3] * v0[3]) + (v1[0] * v1[0] + v1[1] * v1[1]) + (v1[2] * v1[2] + v1[3] * v1[3]);
                    }
                }
                if (!LAST) { ss += __shfl_xor(ss, 16); ss += __shfl_xor(ss, 32); if (fq == 0) atomicAdd(SS + row, ss); }
            }
            asm volatile("" ::: "memory");
        }
    }
};
struct EpiIn {
    static constexpr bool PERM = true, AFTER_DRAIN = false;
    bf16_t *XR, *GL, *Q, *K, *V, *GB; const float *qn, *kn; const float* SS;
    __device__ __forceinline__ void prefetch(float (&pre)[8], const Unit& u, int wr, int fr) const {
        const int row0 = u.pm * BM + wr * 64 + fr;
#pragma unroll
        for (int i = 0; i < 8; ++i) pre[i] = SS[row0 + (i >> 2) * HALF + (i & 3) * 16];
    }
    __device__ __forceinline__ void operator()(const f32x4 (&acc)[2][2][4][2], const Unit& u, int wr, int wc, int fr, int fq, const float (&pre)[8]) const {
        const int row0 = u.pm * BM + wr * 64 + fr, pn = u.pn;
        float rsv[8];
#pragma unroll
        for (int i = 0; i < 8; ++i) rsv[i] = __builtin_amdgcn_rsqf(pre[i] * (1.0f / D) + EPS);
        if (pn < 4 || (pn >= 20 && pn < 24)) {
            bf16_t* O = pn < 4 ? XR : V; const int col0 = (pn < 4 ? pn : pn - 20) * BM + wc * 32 + 8 * fq;
#pragma unroll
            for (int ai = 0; ai < 2; ++ai)
#pragma unroll
                for (int m = 0; m < 4; ++m) {
                    const float rs = rsv[ai * 4 + m];
                    bf16_t* p = O + (size_t)(row0 + ai * HALF + m * 16) * D + col0;
#pragma unroll
                    for (int bj = 0; bj < 2; ++bj) { const f32x4 v0 = acc[ai][bj][m][0] * rs, v1 = acc[ai][bj][m][1] * rs;
                        u32x4 w; w.x = cvt_pk_bf16(v0[0], v0[1]); w.y = cvt_pk_bf16(v0[2], v0[3]); w.z = cvt_pk_bf16(v1[0], v1[1]); w.w = cvt_pk_bf16(v1[2], v1[3]);
                        *(u32x4*)(p + bj * HALF) = w; }
                }
        } else if (pn >= 24) {
            const int col0 = (pn - 24) * BM + wc * 32 + 8 * fq;
#pragma unroll
            for (int ai = 0; ai < 2; ++ai)
#pragma unroll
                for (int m = 0; m < 4; ++m) {
                    const float rn = rsv[ai * 4 + m] * (-LOG2E);
                    bf16_t* p = GB + (size_t)(row0 + ai * HALF + m * 16) * D + col0;
#define SG1(X) frcp(1.0f + fexp2((X) * rn))
#pragma unroll
                    for (int bj = 0; bj < 2; ++bj) { const f32x4 v0 = acc[ai][bj][m][0], v1 = acc[ai][bj][m][1];
                        u32x4 w; w.x = cvt_pk_bf16(SG1(v0[0]), SG1(v0[1])); w.y = cvt_pk_bf16(SG1(v0[2]), SG1(v0[3])); w.z = cvt_pk_bf16(SG1(v1[0]), SG1(v1[1])); w.w = cvt_pk_bf16(SG1(v1[2]), SG1(v1[3]));
                        *(u32x4*)(p + bj * HALF) = w; }
#undef SG1
                }
        } else if (pn < 12) {
            const int col0 = (pn - 4) * 128 + wc * 32 + 8 * fq;
#pragma unroll
            for (int ai = 0; ai < 2; ++ai)
#pragma unroll
                for (int m = 0; m < 4; ++m) {
                    const float rs = rsv[ai * 4 + m], rn = rs * (-LOG2E);
                    bf16_t* p = GL + (size_t)(row0 + ai * HALF + m * 16) * D + col0;
                    const f32x4 g0 = acc[ai][0][m][0] * rs, g1 = acc[ai][0][m][1] * rs, a0 = acc[ai][1][m][0], a1 = acc[ai][1][m][1];
#define GLF(X, A) ((X) * frcp((1.0f + fexp2((-1.5957691216057308f * LOG2E) * ((X) + 0.044715f * (X) * (X) * (X)))) * (1.0f + fexp2((A) * rn))))
                    u32x4 w;
                    w.x = cvt_pk_bf16(GLF(g0[0], a0[0]), GLF(g0[1], a0[1])); w.y = cvt_pk_bf16(GLF(g0[2], a0[2]), GLF(g0[3], a0[3]));
                    w.z = cvt_pk_bf16(GLF(g1[0], a1[0]), GLF(g1[1], a1[1])); w.w = cvt_pk_bf16(GLF(g1[2], a1[2]), GLF(g1[3], a1[3]));
#undef GLF
                    *(u32x4*)p = w;
                }
        } else {
            const bool isq = pn < 16; bf16_t* O = isq ? Q : K; const float* nw = isq ? qn : kn; const float sc = isq ? 0.125f * LOG2E : 1.0f;
            const int head = 4 * (pn - (isq ? 12 : 16)) + wc;
            f32x4 nv[2][2];
#pragma unroll
            for (int bj = 0; bj < 2; ++bj)
#pragma unroll
                for (int n = 0; n < 2; ++n) nv[bj][n] = *(const f32x4*)(nw + 32 * bj + 8 * fq + 4 * n) * sc;
#pragma unroll
            for (int ai = 0; ai < 2; ++ai)
#pragma unroll
                for (int m = 0; m < 4; ++m) {
                    float ss = 0.f;
#pragma unroll
                    for (int bj = 0; bj < 2; ++bj)
#pragma unroll
                        for (int n = 0; n < 2; ++n) { const f32x4 x = acc[ai][bj][m][n]; ss += (x[0] * x[0] + x[1] * x[1]) + (x[2] * x[2] + x[3] * x[3]); }
                    ss += __shfl_xor(ss, 16); ss += __shfl_xor(ss, 32);
                    const float r0 = rsv[ai * 4 + m];
                    const float rs = __builtin_amdgcn_rsqf(ss * (r0 * r0) * (1.0f / 64.0f) + EPS) * r0;
                    bf16_t* p = O + (size_t)(row0 + ai * HALF + m * 16) * D + head * 64 + 8 * fq;
#pragma unroll
                    for (int bj = 0; bj < 2; ++bj) { const f32x4 v0 = acc[ai][bj][m][0] * (nv[bj][0] * rs), v1 = acc[ai][bj][m][1] * (nv[bj][1] * rs);
                        u32x4 w; w.x = cvt_pk_bf16(v0[0], v0[1]); w.y = cvt_pk_bf16(v0[2], v0[3]); w.z = cvt_pk_bf16(v1[0], v1[1]); w.w = cvt_pk_bf16(v1[2], v1[3]);
                        *(u32x4*)(p + 32 * bj) = w; }
                }
        }
    }
};
}

struct Frame {
    LAS unsigned char* lds;
    int tid, lane, wave, vcu, G;
    const float* in[18]; float* out; unsigned char* ws;
};

__device__ __forceinline__ int map_gu(int n) { const int pn = n >> 8, bj = (n >> 7) & 1, i = n & 127; return bj * FF + 128 * pn + i; }
__device__ __forceinline__ int map_in(int n) {
    const int pn = n >> 8, rem = n & 255, bj = rem >> 7, wcw = (rem >> 5) & 3, i = rem & 31;
    if (pn < 4) return n;
    if (pn < 12) return (bj ? 5120 : 1024) + 128 * (pn - 4) + (rem & 127);
    if (pn < 16) return 2048 + 64 * (4 * (pn - 12) + wcw) + 32 * bj + i;
    if (pn < 20) return 3072 + 64 * (4 * (pn - 16) + wcw) + 32 * bj + i;
    if (pn < 24) return 4096 + 256 * (pn - 20) + rem;
    return 6144 + 256 * (pn - 24) + rem;
}
__device__ __forceinline__ void transpose_item(const float* W, int K, int N, int k0, int src_n0, bf16* WT, int dst_row0, LAS float* scr, int lane, const float* gk = nullptr, const float mul = 1.0f) {
#pragma unroll 8
    for (int i = 0; i < 32; ++i) { const int kk = 2 * i + (lane >> 5); const float sc = gk ? gk[k0 + kk] : mul; scr[kk * 33 + (lane & 31)] = W[(size_t)(k0 + kk) * N + src_n0 + (lane & 31)] * sc; }
    asm volatile("s_waitcnt lgkmcnt(0)" ::: "memory");
    const int c = lane & 7;
#pragma unroll
    for (int j = 0; j < 4; ++j) { const int n = (lane >> 3) + 8 * j; const LAS float* s = scr + (8 * c) * 33 + n;
        u32x4 o; o.x = pk2(s[0 * 33], s[1 * 33]); o.y = pk2(s[2 * 33], s[3 * 33]); o.z = pk2(s[4 * 33], s[5 * 33]); o.w = pk2(s[6 * 33], s[7 * 33]);
        *(u32x4*)(WT + (size_t)(dst_row0 + n) * K + k0 + 8 * c) = o; }
    asm volatile("s_waitcnt lgkmcnt(0)" ::: "memory");
}
__device__ __forceinline__ void convert_rows(Frame& F, const float* X, bf16* O, float* SS) {
    const int gw = F.vcu * NWAVES + F.wave, NGW = F.G * NWAVES;
    for (int m = gw; m < M; m += NGW) {
        const f32x4* xr = (const f32x4*)(X + (size_t)m * D) + F.lane;
        f32x4 v[4]; float s = 0.f;
#pragma unroll
        for (int j = 0; j < 4; ++j) { v[j] = xr[64 * j]; s += (v[j].x * v[j].x + v[j].y * v[j].y) + (v[j].z * v[j].z + v[j].w * v[j].w); }
        s = wave_sum(s);
        u32x2* o8 = (u32x2*)(O + (size_t)m * D) + F.lane;
#pragma unroll
        for (int j = 0; j < 4; ++j) { u32x2 w; w.x = pk2(v[j].x, v[j].y); w.y = pk2(v[j].z, v[j].w); o8[64 * j] = w; }
        if (F.lane == 0) SS[m] = s;
    }
}

__device__ __forceinline__ void p0_prologue(Frame& F) {
    LAS float* scr = (LAS float*)(F.lds + F.wave * 16384);
    const int gw = F.vcu * NWAVES + F.wave, NGW = F.G * NWAVES;
    constexpr int I_GU = (D / 64) * (NGU / 32), I_DN = (FF / 64) * (D / 32), I_IN = (D / 64) * (NIN / 32), I_OUT = (D / 64) * (D / 32), I_G = 64 * 2;
    constexpr int NITEMS = 2 * I_GU + 2 * I_DN + I_IN + I_OUT + I_G;
    for (int it = gw; it < NITEMS; it += NGW) {
        int r = it;
        if (r < 2 * I_GU) { const int which = r >= I_GU; r -= which * I_GU; const int nblk = NGU / 32, kb = r / nblk, nb = r % nblk;
            transpose_item(F.in[which ? 16 : 2], D, NGU, 64 * kb, map_gu(32 * nb), (bf16*)(F.ws + (which ? WS_WGU2 : WS_WGU1)), 32 * nb, scr, F.lane, F.in[which ? 15 : 1]); continue; }
        r -= 2 * I_GU;
        if (r < 2 * I_DN) { const int which = r >= I_DN; r -= which * I_DN; const int nblk = D / 32, kb = r / nblk, nb = r % nblk;
            transpose_item(F.in[which ? 17 : 3], FF, D, 64 * kb, 32 * nb, (bf16*)(F.ws + (which ? WS_WDN2 : WS_WDN1)), 32 * nb, scr, F.lane); continue; }
        r -= 2 * I_DN;
        if (r < I_IN) { const int nblk = NIN / 32, kb = r / nblk, nb = r % nblk;
            transpose_item(F.in[5], D, NIN, 64 * kb, map_in(32 * nb), (bf16*)(F.ws + WS_WIN), 32 * nb, scr, F.lane, F.in[4]); continue; }
        r -= I_IN;
        if (r < I_OUT) { const int nblk = D / 32, kb = r / nblk, nb = r % nblk;
            transpose_item(F.in[14], D, D, 64 * kb, 32 * nb, (bf16*)(F.ws + WS_WOUT), 32 * nb, scr, F.lane); continue; }
        r -= I_OUT;
        { const int mat = r >> 1, nb = r & 1;
          transpose_item(F.in[8] + (size_t)mat * 4096, 64, 64, 0, 32 * nb, (bf16*)(F.ws + WS_WG) + (size_t)mat * 4096, 32 * nb, scr, F.lane, nullptr, -LOG2E); }
    }
    { float* z = (float*)(F.ws + WS_SS1); for (int i = (int)blockIdx.x * (NWAVES * 64) + F.tid; i < 2 * M; i += F.G * NWAVES * 64) z[i] = 0.f; }
    convert_rows(F, F.in[0], (bf16*)(F.ws + WS_HB), (float*)(F.ws + WS_SS0));
}

__device__ __forceinline__ void scan_phase(Frame& F) {
    const int tid = F.tid, lane = F.lane, w = F.wave, fr = lane & 15, fq = lane >> 4;
    constexpr int XC_B = 34816, XCB_B = 18432;
    LAS unsigned short* XCB = (LAS unsigned short*)(F.lds + 2 * XC_B);
    LAS float* AA = (LAS float*)(F.lds + 2 * XC_B + XCB_B);
    LAS float* AGG = (LAS float*)(F.lds + 3 * XC_B + XCB_B);
    LAS float* CAR = (LAS float*)(F.lds + 3 * XC_B + XCB_B + 4096);
    LAS float* CWL = (LAS float*)(F.lds + 3 * XC_B + XCB_B + 4096 + 512);
    LAS bf16x8* WFL = (LAS bf16x8*)(F.lds + 3 * XC_B + XCB_B + 4096 + 512 + 1280);
    static_assert(3 * XC_B + XCB_B + 4096 + 512 + 1280 + 16384 <= LDS_BYTES, "scan LDS map");
    const bf16* XR = (const bf16*)(F.ws + WS_XR); bf16* GL = (bf16*)(F.ws + WS_GL); bf16* HF = (bf16*)F.out;
    const bf16* WG = (const bf16*)(F.ws + WS_WG);
    const float* conv_w = F.in[6]; const float* conv_b = F.in[7]; const float* bg = F.in[9]; const float* lam = F.in[10];
    const int c = tid & 7, tokb = tid >> 3;
    for (int u = blockIdx.x; u < BATCH * 16; u += F.G) {
        const int b = u >> 4, n = u & 15, chb = n * 64; const size_t rowbase = (size_t)b * SEQ;
        __syncthreads();
        if (tid < 256) CWL[tid] = conv_w[(tid >> 6) * D + chb + (tid & 63)]; else if (tid < 320) CWL[tid] = conv_b[chb + (tid & 63)];
        const bf16* xrp = XR + rowbase * D + chb + 8 * c;
        for (int dir = 0; dir < 2; ++dir) {
            float br[4], bi[4], c8[4];
            __syncthreads();
#pragma unroll
            for (int q = 0; q < 2; ++q) { const int idx = 2 * w + q, g = idx >> 3, ct = (idx >> 1) & 3, ks = idx & 1;
                WFL[idx * 64 + lane] = *(const bf16x8*)(WG + ((size_t)((dir * 2 + g) * 16 + n) * 64 + 16 * ct + fr) * 64 + 8 * fq + 32 * ks); }
#pragma unroll
            for (int ct = 0; ct < 4; ++ct) { const int ch = chb + 16 * ct + fr;
                br[ct] = bg[(dir * 2 + 0) * D + ch] * (-LOG2E); bi[ct] = bg[(dir * 2 + 1) * D + ch] * (-LOG2E);
                const float l = lam[dir * D + ch]; const float sp = fmaxf(-l, 0.f) + log1pf(__expf(-fabsf(l)));
                c8[ct] = 8.0f * sp * LOG2E; }
            if (tid < 64) CAR[tid] = 0.f;
            u32x4 xv[5];
#define SCAN_LOADX(T0) do { _Pragma("unroll") for (int k = 0; k < 5; ++k) { const int tt = (T0) + 2 * tokb + k - 2; \
                xv[k] = (tt >= 0 && tt < SEQ) ? *(const u32x4*)(xrp + (size_t)tt * D) : (u32x4){0u, 0u, 0u, 0u}; } } while (0)
            SCAN_LOADX(dir == 0 ? 0 : SEQ - 128);
            __syncthreads();
            for (int tile = 0; tile < SEQ / 128; ++tile) {
                const int t0 = (dir == 0 ? tile : (SEQ / 128 - 1 - tile)) * 128, pb = tile & 1;
                LAS float* XC = (LAS float*)(F.lds + pb * XC_B);
#pragma unroll
                for (int it = 0; it < 2; ++it) {
                    const int tok = 2 * tokb + it;
                    float a8[8];
                    { const f32x4 b0 = *(const LAS f32x4*)(CWL + 256 + 8 * c), b1 = *(const LAS f32x4*)(CWL + 256 + 8 * c + 4);
                      a8[0] = b0[0]; a8[1] = b0[1]; a8[2] = b0[2]; a8[3] = b0[3]; a8[4] = b1[0]; a8[5] = b1[1]; a8[6] = b1[2]; a8[7] = b1[3]; }
#pragma unroll
                    for (int k = 0; k < 4; ++k) { const u32x4 v = xv[it + k];
                        const f32x4 w0 = *(const LAS f32x4*)(CWL + 64 * k + 8 * c), w1 = *(const LAS f32x4*)(CWL + 64 * k + 8 * c + 4);
                        a8[0] += w0[0] * bf_lo(v[0]); a8[1] += w0[1] * bf_hi(v[0]); a8[2] += w0[2] * bf_lo(v[1]); a8[3] += w0[3] * bf_hi(v[1]);
                        a8[4] += w1[0] * bf_lo(v[2]); a8[5] += w1[1] * bf_hi(v[2]); a8[6] += w1[2] * bf_lo(v[3]); a8[7] += w1[3] * bf_hi(v[3]); }
                    *(LAS f32x4*)(XC + tok * 68 + 8 * c) = (f32x4){a8[0], a8[1], a8[2], a8[3]};
                    *(LAS f32x4*)(XC + tok * 68 + 8 * c + 4) = (f32x4){a8[4], a8[5], a8[6], a8[7]};
                    u32x4 pw; pw.x = pk2(a8[0], a8[1]); pw.y = pk2(a8[2], a8[3]); pw.z = pk2(a8[4], a8[5]); pw.w = pk2(a8[6], a8[7]);
                    *(LAS u32x4*)(XCB + tok * 72 + 8 * c) = pw;
                }
                if (tile + 1 < SEQ / 128) SCAN_LOADX(dir == 0 ? t0 + 128 : t0 - 128);
                __syncthreads();
                {
                    const bf16x8 a0 = *(const LAS bf16x8*)(XCB + (16 * w + fr) * 72 + 8 * fq), a1 = *(const LAS bf16x8*)(XCB + (16 * w + fr) * 72 + 8 * fq + 32);
#pragma unroll
                    for (int ct = 0; ct < 4; ++ct) {
                        f32x4 gr = {br[ct], br[ct], br[ct], br[ct]}, gi = {bi[ct], bi[ct], bi[ct], bi[ct]};
                        gr = __builtin_amdgcn_mfma_f32_16x16x32_bf16(a0, WFL[(ct * 2 + 0) * 64 + lane], gr, 0, 0, 0); gr = __builtin_amdgcn_mfma_f32_16x16x32_bf16(a1, WFL[(ct * 2 + 1) * 64 + lane], gr, 0, 0, 0);
                        gi = __builtin_amdgcn_mfma_f32_16x16x32_bf16(a0, WFL[(8 + ct * 2 + 0) * 64 + lane], gi, 0, 0, 0); gi = __builtin_amdgcn_mfma_f32_16x16x32_bf16(a1, WFL[(8 + ct * 2 + 1) * 64 + lane], gi, 0, 0, 0);
#pragma unroll
                        for (int jj = 0; jj < 4; ++jj) { const int idx = (16 * w + 4 * fq + jj) * 68 + 16 * ct + fr;
                            const float xc = XC[idx]; const float r = frcp(1.0f + fexp2(gr[jj])), ig = frcp(1.0f + fexp2(gi[jj]));
                            const float a = fexp2(-c8[ct] * r); const float bx = __builtin_amdgcn_sqrtf(1.0f - a * a) * (ig * xc);
                            AA[idx] = a; XC[idx] = bx; }
                    }
                }
                u32x4 hfv[2], glv[2];
                if (dir == 1) {
#pragma unroll
                    for (int it = 0; it < 2; ++it) { const size_t g = (rowbase + t0 + 2 * tokb + it) * D + chb + 8 * c; hfv[it] = *(const u32x4*)(HF + g); glv[it] = *(const u32x4*)(GL + g); }
                }
                __syncthreads();
                {
                    float h = 0.f, P = 1.f;
#pragma unroll
                    for (int k = 0; k < 16; ++k) { const int tk = dir == 0 ? 16 * w + k : 16 * w + 15 - k; const float a = AA[tk * 68 + lane], bx = XC[tk * 68 + lane]; h = a * h + bx; P *= a; }
                    AGG[(w * 64 + lane) * 2] = P; AGG[(w * 64 + lane) * 2 + 1] = h;
                }
                __syncthreads();
                {
                    const int cur = tile & 1; float h = CAR[cur * 64 + lane];
                    if (dir == 0) { for (int s2 = 0; s2 < w; ++s2) h = AGG[(s2 * 64 + lane) * 2] * h + AGG[(s2 * 64 + lane) * 2 + 1]; }
                    else { for (int s2 = 7; s2 > w; --s2) h = AGG[(s2 * 64 + lane) * 2] * h + AGG[(s2 * 64 + lane) * 2 + 1]; }
#pragma unroll
                    for (int k = 0; k < 16; ++k) { const int tk = dir == 0 ? 16 * w + k : 16 * w + 15 - k; const float a = AA[tk * 68 + lane], bx = XC[tk * 68 + lane]; h = a * h + bx; XC[tk * 68 + lane] = h; }
                    if (w == (dir == 0 ? 7 : 0)) CAR[(cur ^ 1) * 64 + lane] = h;
                }
                __syncthreads();
#pragma unroll
                for (int it = 0; it < 2; ++it) {
                    const int tok = 2 * tokb + it;
                    const f32x4 h0 = *(const LAS f32x4*)(XC + tok * 68 + 8 * c), h1 = *(const LAS f32x4*)(XC + tok * 68 + 8 * c + 4);
                    const size_t g = (rowbase + t0 + tok) * D + chb + 8 * c;
                    if (dir == 0) { u32x4 pw; pw.x = pk2(h0[0], h0[1]); pw.y = pk2(h0[2], h0[3]); pw.z = pk2(h1[0], h1[1]); pw.w = pk2(h1[2], h1[3]); *(u32x4*)(HF + g) = pw; }
                    else { const u32x4 hf = hfv[it], gl = glv[it]; u32x4 pw;
                        pw.x = pk2(bf_lo(gl.x) * (bf_lo(hf.x) + h0[0]), bf_hi(gl.x) * (bf_hi(hf.x) + h0[1])); pw.y = pk2(bf_lo(gl.y) * (bf_lo(hf.y) + h0[2]), bf_hi(gl.y) * (bf_hi(hf.y) + h0[3]));
                        pw.z = pk2(bf_lo(gl.z) * (bf_lo(hf.z) + h1[0]), bf_hi(gl.z) * (bf_hi(hf.z) + h1[1])); pw.w = pk2(bf_lo(gl.w) * (bf_lo(hf.w) + h1[2]), bf_hi(gl.w) * (bf_hi(hf.w) + h1[3]));
                        *(u32x4*)(GL + g) = pw; }
                }
            }
            __syncthreads();
#undef SCAN_LOADX
        }
    }
}

__device__ __forceinline__ void attn_phase(Frame& F) {
    const int tid = F.tid, lane = F.lane, w = F.wave, fr = lane & 15, fq = lane >> 4;
    constexpr int VS = 488, VT_B = 64 * VS * 2, TAB_B = 4096, TAB_MASK = 512;
    static_assert(2 * VT_B + 2 * TAB_B <= LDS_BYTES, "attention LDS map");
    const bf16* Qb = (const bf16*)(F.ws + WS_Q); const bf16* Kb = (const bf16*)(F.ws + WS_K); const bf16* Vb = (const bf16*)(F.ws + WS_V);
    const bf16* GB = (const bf16*)(F.ws + WS_GB); bf16* Y = (bf16*)(F.ws + WS_GL);
    const float* rpb = F.in[13];
    constexpr int NU = BATCH * NH * 4 * 4;
    const bool contig = (NU % F.G) == 0; const int nun = contig ? NU / F.G : (NU - (int)blockIdx.x + F.G - 1) / F.G;
#define ATT_UNIT(i) (contig ? F.vcu * nun + (i) : (int)blockIdx.x + (i) * F.G)
    float SHIFT;
    { float mq = fabsf(F.in[11][lane]), mk = fabsf(F.in[12][lane]);
#pragma unroll
      for (int o = 1; o < 64; o <<= 1) { mq = fmaxf(mq, __shfl_xor(mq, o)); mk = fmaxf(mk, __shfl_xor(mk, o)); }
      SHIFT = 8.0f * LOG2E * 1.02f * mq * mk; }
    u32x4 nv[8]; float tabv = 0.f;
#define ATT_GEOM(u_, rg_, nb_, h_, b_, rmin_, nkeys_, kstart_) const int rg_ = (u_) & 3, nb_ = ((u_) >> 2) & 3, h_ = ((u_) >> 4) & 15, b_ = (u_) >> 8; \
        const int rmin_ = min(max(8 * rg_ - 4, 0), ROWS - 8), nkeys_ = (min(max(8 * rg_ + 3, 0), ROWS - 8) + 8 - rmin_) * 32, kstart_ = min(max(nb_ * 16 - 8, 0), GW - 32);
#define ATT_LOADV(u_) do { ATT_GEOM(u_, rg_, nb_, h_, b_, rmin_, nkeys_, kstart_) (void)rg_; \
        _Pragma("unroll") for (int it = 0; it < 8; ++it) { const int id = it * 512 + tid, cc = id / 480, key = id - cc * 480; \
            nv[it] = (id < 3840 && key < nkeys_) ? *(const u32x4*)(Vb + ((size_t)b_ * SEQ + (rmin_ + (key >> 5)) * GW + kstart_ + (key & 31)) * D + h_ * HD + 8 * cc) : (u32x4){0u, 0u, 0u, 0u}; } \
        tabv = tid < 465 ? rpb[h_ * 465 + tid] * LOG2E - SHIFT : -1e30f; } while (0)
#define ATT_WRITEV(u_, buf_) do { ATT_GEOM(u_, rg_, nb_, h_, b_, rmin_, nkeys_, kstart_) (void)rg_; (void)nb_; (void)h_; (void)b_; (void)rmin_; (void)kstart_; \
        LAS unsigned short* VTw = (LAS unsigned short*)(F.lds + (buf_) * VT_B); \
        _Pragma("unroll") for (int it = 0; it < 8; ++it) { const int id = it * 512 + tid, cc = id / 480, key = id - cc * 480; \
            if (id < 3840 && key < nkeys_) { _Pragma("unroll") for (int e = 0; e < 4; ++e) { VTw[(8 * cc + 2 * e) * VS + key] = (unsigned short)(nv[it][e] & 0xffffu); VTw[(8 * cc + 2 * e + 1) * VS + key] = (unsigned short)(nv[it][e] >> 16); } } } \
        { LAS float* tw_ = (LAS float*)(F.lds + 2 * VT_B + (buf_) * TAB_B); tw_[tid] = tabv; tw_[512 + tid] = -1e30f; } } while (0)
    bf16x8 qpre[2], kpre[8];
#define ATT_LOADQK(u_) do { ATT_GEOM(u_, rg_, nb_, h_, b_, rmin_, nkeys_, kstart_) (void)rmin_; (void)nkeys_; \
        const int r_ = 8 * rg_ + w, rs_ = min(max(r_ - 4, 0), ROWS - 8); const size_t rb_ = (size_t)b_ * SEQ; \
        const bf16* qp_ = Qb + (rb_ + r_ * GW + nb_ * 16 + fr) * D + h_ * HD + 8 * fq; qpre[0] = *(const bf16x8*)qp_; qpre[1] = *(const bf16x8*)(qp_ + 32); \
        _Pragma("unroll") for (int nt = 0; nt < 4; ++nt) { const bf16* kp_ = Kb + (rb_ + (rs_ + (nt >> 1)) * GW + kstart_ + (nt & 1) * 16 + fr) * D + h_ * HD + 8 * fq; \
            kpre[2 * nt] = *(const bf16x8*)kp_; kpre[2 * nt + 1] = *(const bf16x8*)(kp_ + 32); } } while (0)
    if (nun > 0) { const int u0 = ATT_UNIT(0); ATT_LOADV(u0); ATT_LOADQK(u0); ATT_WRITEV(u0, 0); }
    __syncthreads();
    for (int i = 0; i < nun; ++i) {
        const int u = ATT_UNIT(i), cur = i & 1;
        const LAS unsigned short* VT = (const LAS unsigned short*)(F.lds + cur * VT_B);
        const LAS float* TAB = (const LAS float*)(F.lds + 2 * VT_B + cur * TAB_B);
        ATT_GEOM(u, rg, nb, h, b, rmin, nkeys, kstart) (void)nkeys;
        const size_t rowbase = (size_t)b * SEQ;
        if (i + 1 < nun) { const int un = ATT_UNIT(i + 1); ATT_LOADV(un); }
        {
            const int r = 8 * rg + w, rs = min(max(r - 4, 0), ROWS - 8), koff = (rs - rmin) * 32;
            const int qc = nb * 16 + fr, cs = min(max(qc - 8, 0), GW - 16);
            const bf16x8 qf0 = qpre[0], qf1 = qpre[1];
            const size_t g0 = (rowbase + r * GW + qc) * D + h * HD + 4 * fq;
            u32x2 yv[4], gv[4];
#pragma unroll
            for (int dt = 0; dt < 4; ++dt) { yv[dt] = *(const u32x2*)(Y + g0 + 16 * dt); gv[dt] = *(const u32x2*)(GB + g0 + 16 * dt); }
            int dcx[8];
#pragma unroll
            for (int e = 0; e < 8; ++e) { const int kc = kstart + (e >> 2) * 16 + 4 * fq + (e & 3); dcx[e] = ((kc >= cs) && (kc < cs + 16)) ? min(max(kc - qc, -15), 15) + 15 + (rs - r + 7) * 31 : TAB_MASK; }
            f32x4 st[16];
#pragma unroll
            for (int nt = 0; nt < 16; ++nt) {
                bf16x8 kf0, kf1;
                if (nt < 4) { kf0 = kpre[2 * nt]; kf1 = kpre[2 * nt + 1]; }
                else { const int token = (rs + (nt >> 1)) * GW + kstart + (nt & 1) * 16 + fr;
                    const bf16* kp = Kb + (rowbase + token) * D + h * HD + 8 * fq;
                    kf0 = *(const bf16x8*)kp; kf1 = *(const bf16x8*)(kp + 32); }
                f32x4 z;
#pragma unroll
                for (int jj = 0; jj < 4; ++jj) z[jj] = TAB[(nt >> 1) * 31 + dcx[(nt & 1) * 4 + jj]];
                z = __builtin_amdgcn_mfma_f32_16x16x32_bf16(kf0, qf0, z, 0, 0, 0);
                st[nt] = __builtin_amdgcn_mfma_f32_16x16x32_bf16(kf1, qf1, z, 0, 0, 0);
            }
#pragma unroll
            for (int nt = 0; nt < 16; ++nt)
#pragma unroll
                for (int jj = 0; jj < 4; ++jj) st[nt][jj] = fexp2(st[nt][jj]);
            bf16x8 pb[8];
#pragma unroll
            for (int ks = 0; ks < 8; ++ks) { u32x4 pw; pw.x = pk2(st[2 * ks][0], st[2 * ks][1]); pw.y = pk2(st[2 * ks][2], st[2 * ks][3]); pw.z = pk2(st[2 * ks + 1][0], st[2 * ks + 1][1]); pw.w = pk2(st[2 * ks + 1][2], st[2 * ks + 1][3]);
                pb[ks] = __builtin_bit_cast(bf16x8, pw); }
            f32x4 o[4];
#pragma unroll
            for (int dt = 0; dt < 4; ++dt) { o[dt] = (f32x4){0.f, 0.f, 0.f, 0.f};
#pragma unroll
                for (int ks = 0; ks < 8; ++ks) { const LAS unsigned short* vp = VT + (16 * dt + fr) * VS + koff + 32 * ks + 4 * fq;
                    const u32x2 lo = *(const LAS u32x2*)vp, hi = *(const LAS u32x2*)(vp + 16);
                    const u32x4 av = {lo.x, lo.y, hi.x, hi.y};
                    o[dt] = __builtin_amdgcn_mfma_f32_16x16x32_bf16(__builtin_bit_cast(bf16x8, av), pb[ks], o[dt], 0, 0, 0); } }
            f32x4 ls = {0.f, 0.f, 0.f, 0.f};
            { const u32x4 one4 = {0x3f803f80u, 0x3f803f80u, 0x3f803f80u, 0x3f803f80u}; const bf16x8 ones = __builtin_bit_cast(bf16x8, one4);
#pragma unroll
              for (int ks = 0; ks < 8; ++ks) ls = __builtin_amdgcn_mfma_f32_16x16x32_bf16(ones, pb[ks], ls, 0, 0, 0); }
            const float inv = frcp(ls[0]);
#pragma unroll
            for (int dt = 0; dt < 4; ++dt) { const size_t g = g0 + 16 * dt; u32x2 ov;
                ov.x = pk2(bf_lo(yv[dt].x) + bf_lo(gv[dt].x) * o[dt][0] * inv, bf_hi(yv[dt].x) + bf_hi(gv[dt].x) * o[dt][1] * inv);
                ov.y = pk2(bf_lo(yv[dt].y) + bf_lo(gv[dt].y) * o[dt][2] * inv, bf_hi(yv[dt].y) + bf_hi(gv[dt].y) * o[dt][3] * inv);
                *(u32x2*)(Y + g) = ov; }
        }
        if (i + 1 < nun) { const int un = ATT_UNIT(i + 1); ATT_LOADQK(un); ATT_WRITEV(un, cur ^ 1); }
        __syncthreads();
    }
#undef ATT_UNIT
#undef ATT_GEOM
#undef ATT_LOADV
#undef ATT_LOADQK
#undef ATT_WRITEV
}

struct Args { const float* in[18]; float* out; unsigned char* ws; int ph_lo, ph_hi, coop, pad; };
constexpr int N_PHASES = 9;
__global__ void __launch_bounds__(NWAVES * 64, 2) mk_fwd(Args args) {
    extern __shared__ __attribute__((aligned(16))) unsigned char lds[];
    Frame F;
    F.lds = (LAS unsigned char*)lds;
    F.tid = threadIdx.x; F.lane = F.tid & 63; F.wave = __builtin_amdgcn_readfirstlane(F.tid >> 6);
    F.G = gridDim.x; { const int bx = blockIdx.x; F.vcu = (F.G % 8 == 0) ? (bx % 8) * (F.G / 8) + bx / 8 : bx; }
#pragma unroll
    for (int i = 0; i < 18; ++i) F.in[i] = args.in[i];
    F.out = args.out; F.ws = args.ws;
    unsigned char* ws = args.ws;
    const int lo = args.ph_lo, hi = args.ph_hi; const bool coop = args.coop != 0;
#define IN(k) (lo <= (k) && (k) < hi)
    volatile LAS unsigned* MISC = (volatile LAS unsigned*)(F.lds + LDS_BYTES - 16);
    if (F.tid < 4) MISC[F.tid] = 0u;
    if (coop && lo == 0 && blockIdx.x == 0) { unsigned* bw = (unsigned*)(ws + WS_BAR); for (int i = F.tid; i < XCD_BAR_WORDS; i += NWAVES * 64) bw[i] = 0u; }
    __syncthreads();
    XcdBarrier bar; bar.bar = (unsigned*)(ws + WS_BAR); bar.x = 0; bar.st = MISC;
#define SEAM(k) do { if (coop && IN(k) && IN((k) + 1)) { if ((k) == 0) { cg::this_grid().sync(); bar = xcd_barrier_post((unsigned*)(ws + WS_BAR), MISC); } else { xcd_barrier(bar); } } } while (0)
    bf16* HB = (bf16*)(ws + WS_HB); bf16* ACT = (bf16*)(ws + WS_ACT);

    if (IN(0)) { p0_prologue(F); } SEAM(0);
    float* SS0 = (float*)(ws + WS_SS0); float* SS1 = (float*)(ws + WS_SS1); float* SS2 = (float*)(ws + WS_SS2);
    if (IN(1)) { pg8::Gemm g{HB, (const bf16*)(ws + WS_WGU1), M, NGU, D}; pg8::StaticOrder S; S.init(M, NGU, F.G, (int)blockIdx.x);
        pg8::EpiGU E{ACT, SS0}; pg8::gemm_phase<pg8::EpiGU, pg8::StaticOrder, PG8_ALIGN, PG8_SP2>(F.lds, g, S, E); } SEAM(1);
    if (IN(2)) { pg8::Gemm g{ACT, (const bf16*)(ws + WS_WDN1), M, D, FF}; pg8::StaticOrder S; S.init(M, D, F.G, (int)blockIdx.x); S.rev = true;
        pg8::EpiRes<false, true> E{HB, nullptr, SS1}; pg8::gemm_phase<pg8::EpiRes<false, true>, pg8::StaticOrder, PG8_ALIGN, PG8_SP2>(F.lds, g, S, E); } SEAM(2);
    if (IN(3)) { pg8::Gemm g{HB, (const bf16*)(ws + WS_WIN), M, NIN, D}; pg8::StaticOrder S; S.init(M, NIN, F.G, (int)blockIdx.x);
        pg8::EpiIn E{(bf16*)(ws + WS_XR), (bf16*)(ws + WS_GL), (bf16*)(ws + WS_Q), (bf16*)(ws + WS_K), (bf16*)(ws + WS_V), (bf16*)(ws + WS_GB), F.in[11], F.in[12], SS1};
        pg8::gemm_phase<pg8::EpiIn, pg8::StaticOrder, PG8_ALIGN, PG8_SP2>(F.lds, g, S, E); } SEAM(3);
    if (IN(4)) { scan_phase(F); } SEAM(4);
    if (IN(5)) { attn_phase(F); } SEAM(5);
    if (IN(6)) { pg8::Gemm g{(const bf16*)(ws + WS_GL), (const bf16*)(ws + WS_WOUT), M, D, D}; pg8::StaticOrder S; S.init(M, D, F.G, (int)blockIdx.x);
        pg8::EpiRes<false, false> E{HB, nullptr, SS2}; pg8::gemm_phase<pg8::EpiRes<false, false>, pg8::StaticOrder, PG8_ALIGN, PG8_SP2>(F.lds, g, S, E); } SEAM(6);
    if (IN(7)) { pg8::Gemm g{HB, (const bf16*)(ws + WS_WGU2), M, NGU, D}; pg8::StaticOrder S; S.init(M, NGU, F.G, (int)blockIdx.x);
        pg8::EpiGU E{ACT, SS2}; pg8::gemm_phase<pg8::EpiGU, pg8::StaticOrder, PG8_ALIGN, PG8_SP2>(F.lds, g, S, E); } SEAM(7);
    if (IN(8)) { pg8::Gemm g{ACT, (const bf16*)(ws + WS_WDN2), M, D, FF}; pg8::StaticOrder S; S.init(M, D, F.G, (int)blockIdx.x); S.rev = true;
        pg8::EpiRes<true, true> E{HB, F.out, nullptr}; pg8::gemm_phase<pg8::EpiRes<true, true>, pg8::StaticOrder, PG8_ALIGN, PG8_SP2>(F.lds, g, S, E); }
#undef IN
#undef SEAM
}

extern "C" void kernel_launch(void* const* d_in, const int* in_sizes, int n_in, void* d_out, int out_size, void* d_ws, size_t ws_size, hipStream_t stream) {
    static int grid = 0;
    if (grid == 0) {
        if (n_in != 18 || in_sizes[0] != M * D || out_size != M * D || ws_size < WS_END) { fprintf(stderr, "kernel_launch: shape/workspace mismatch (n_in %d, in0 %d, out %d, ws %zu, need %zu)\n", n_in, n_in > 0 ? in_sizes[0] : -1, out_size, ws_size, (size_t)WS_END); grid = -1; return; }
        int dev = 0, cus = 0, per_cu = 0;
        if (hipGetDevice(&dev) != hipSuccess || hipDeviceGetAttribute(&cus, hipDeviceAttributeMultiprocessorCount, dev) != hipSuccess) { grid = -1; return; }
        if (hipFuncSetAttribute((const void*)mk_fwd, hipFuncAttributeMaxDynamicSharedMemorySize, LDS_BYTES) != hipSuccess) { fprintf(stderr, "kernel_launch: hipFuncSetAttribute failed\n"); grid = -1; return; }
        if (hipOccupancyMaxActiveBlocksPerMultiprocessor(&per_cu, (const void*)mk_fwd, NWAVES * 64, LDS_BYTES) != hipSuccess || per_cu < 1) { fprintf(stderr, "kernel_launch: occupancy query says %d blocks per CU\n", per_cu); per_cu = 1; }
        (void)hipGetLastError();
        grid = cus * 1;
    }
    if (grid < 0) return;
    Args a{};
    for (int i = 0; i < 18; ++i) a.in[i] = (const float*)d_in[i];
    a.out = (float*)d_out; a.ws = (unsigned char*)d_ws;
#if MK_MULTI
    for (int p = 0; p < N_PHASES; ++p) { a.ph_lo = p; a.ph_hi = p + 1; a.coop = 0; hipLaunchKernelGGL(mk_fwd, dim3(grid), dim3(NWAVES * 64), LDS_BYTES, stream, a); }
#else
    a.ph_lo = 0; a.ph_hi = N_PHASES; a.coop = 1;
    void* kargs[] = {&a};
    hipError_t e = hipLaunchCooperativeKernel((const void*)mk_fwd, dim3(grid), dim3(NWAVES * 64), kargs, LDS_BYTES, stream);
    if (e != hipSuccess) fprintf(stderr, "kernel_launch: cooperative launch failed: %s (grid %d)\n", hipGetErrorString(e), grid);
#endif
}
```

```cpp
#include <hip/hip_runtime.h>
#include <hip/hip_cooperative_groups.h>
#include <cstdio>
#include <cstdint>
namespace cg = cooperative_groups;
namespace pg8 {
#define PG8_LAS __attribute__((address_space(3)))
typedef unsigned short bf16_t;
typedef short bf16x8 __attribute__((ext_vector_type(8)));
typedef float f32x4 __attribute__((ext_vector_type(4)));
typedef unsigned u32x4 __attribute__((ext_vector_type(4)));
constexpr int BM = 256, BK = 64, HALF = 128, HTB = HALF * BK * 2  , STAGE_BYTES = 8 * HTB, NXCD = 8, WGM = 8;

__host__ __device__ __forceinline__ int lds_byte(int r, int c) { const int st = (r >> 4) * 2 + (c >> 5), rr = r & 15, cc = c & 31, ob = rr * 64 + cc * 2; return st * 1024 + (ob ^ (((ob >> 9) & 1) << 5)); }
__host__ __device__ __forceinline__ void stage_rc(int b, int& R, int& C) { const int st = b / 1024, sb = b % 1024, swz = sb ^ (((sb >> 9) & 1) << 5); R = (st >> 1) * 16 + swz / 64; C = (st & 1) * 32 + (swz % 64) / 2; }
__host__ __device__ __forceinline__ int perm32(int rho) { const int n = rho >> 4, i = rho & 15; return 8 * (i >> 2) + 4 * n + (i & 3); }

struct Unit { int pm, pn; };
struct Gemm { const bf16_t* A; const bf16_t* Bt; int M, N, K; };

struct StaticOrder {
    int nM, nN, nwg, G, c; bool rev = false;
    __host__ __device__ void init(int M, int N, int G_, int c_) { nM = M / BM; nN = N / BM; nwg = nM * nN; G = G_; c = c_; }
    __host__ __device__ bool next(int i, Unit& u) const {
        const long L = (long)i * G + c; if (L >= nwg) return false;
        int wgid = (int)L; { const int q = nwg / NXCD, r = nwg % NXCD, xcd = wgid % NXCD, off = wgid / NXCD; wgid = (xcd < r ? xcd * (q + 1) : r * (q + 1) + (xcd - r) * q) + off; }
        const int nig = WGM * nN, gid = wgid / nig, fm = gid * WGM, gsz = (nM - fm) < WGM ? (nM - fm) : WGM;
        u.pm = fm + ((wgid % nig) % gsz); u.pn = (wgid % nig) / gsz; if (rev) u.pm = nM - 1 - u.pm; return true;
    }
    __device__ __forceinline__ void a_ready(const Unit&) const {}
    __device__ __forceinline__ void done(const Unit&) const {}
};

typedef float f32x2_cv __attribute__((ext_vector_type(2))); typedef __bf16 bf16x2_cv __attribute__((ext_vector_type(2)));
__device__ __forceinline__ unsigned cvt_pk_bf16(float lo, float hi) { f32x2_cv v = {lo, hi}; bf16x2_cv b = __builtin_convertvector(v, bf16x2_cv); return __builtin_bit_cast(unsigned, b); }
template <class Epi, class Sched, bool ALIGN_EPI = false, bool SP2 = false>
__device__ __forceinline__ void gemm_phase(PG8_LAS unsigned char* lds, const Gemm g, const Sched& S, const Epi& E) {
    const int tid = threadIdx.x, wid = __builtin_amdgcn_readfirstlane(tid >> 6), lane = tid & 63, wr = wid >> 2, wc = wid & 3, fr = lane & 15, fq = lane >> 4;
    const int K = g.K, nt = K / BK;
    unsigned voffA[2], voffB[2];
#pragma unroll
    for (int i = 0; i < 2; ++i) { int R, C; stage_rc(tid * 16 + i * 8192, R, C); const int Rb = Epi::PERM ? ((R & ~31) + perm32(R & 31)) : R;
        voffA[i] = (unsigned)(R * K + C) * 2u; voffB[i] = (unsigned)(Rb * K + C) * 2u; }
    const size_t kstep = (size_t)(BK * 2);
    const size_t hstep = (size_t)HALF * K * 2;
    const size_t tstep = 2 * hstep;
    const unsigned ldsw = (unsigned)wid * 1024u;
    const int aoff = lds_byte(wr * 64 + fr, fq * 8), boff = lds_byte(wc * 32 + fr, fq * 8);
#define PG8_SA(b, h) (((b) * 2 + (h)) * HTB)
#define PG8_SB(b, h) ((4 + (b) * 2 + (h)) * HTB)
#define PG8_STAGE(bufoff, gbase, voff) do { _Pragma("unroll") for (int _i = 0; _i < 2; ++_i) \
        __builtin_amdgcn_global_load_lds((const unsigned*)((const char*)(gbase) + (voff)[_i]), (PG8_LAS unsigned*)(lds + (bufoff) + ldsw + _i * 8192), 16, 0, 0); } while (0)
#define PG8_LDA(dst, b, h) do { _Pragma("unroll") for (int m = 0; m < 4; ++m) _Pragma("unroll") for (int k = 0; k < 2; ++k) dst[m][k] = *(const PG8_LAS bf16x8*)(lds + PG8_SA(b, h) + aoff + m * 2048 + k * 1024); } while (0)
#define PG8_LDB(dst, b, h) do { _Pragma("unroll") for (int n = 0; n < 2; ++n) _Pragma("unroll") for (int k = 0; k < 2; ++k) dst[n][k] = *(const PG8_LAS bf16x8*)(lds + PG8_SB(b, h) + boff + n * 2048 + k * 1024); } while (0)
#define PG8_MMA(ai, bj, At, Bt) do { __builtin_amdgcn_s_setprio(1); _Pragma("unroll") for (int m = 0; m < 4; ++m) _Pragma("unroll") for (int n = 0; n < 2; ++n) _Pragma("unroll") for (int k = 0; k < 2; ++k) \
        acc[ai][bj][m][n] = __builtin_amdgcn_mfma_f32_16x16x32_bf16(Bt[n][k], At[m][k], acc[ai][bj][m][n], 0, 0, 0); __builtin_amdgcn_s_setprio(0); } while (0)
#define PG8_WAIT_V(n) asm volatile("s_waitcnt vmcnt(" #n ")" ::: "memory")
#define PG8_WAIT_L(n) asm volatile("s_waitcnt lgkmcnt(" #n ")" ::: "memory")
#define PG8_BAR __builtin_amdgcn_s_barrier()
#define PG8_SCHED __builtin_amdgcn_sched_barrier(0)
    Unit cur, nxt; int ui = 0;
    float epi_pre[8];
#pragma unroll
    for (int i = 0; i < 8; ++i) epi_pre[i] = 0.f;
    if (!S.next(0, cur)) return;
    f32x4 acc[2][2][4][2];
#pragma unroll
    for (int a = 0; a < 2; ++a)
#pragma unroll
        for (int b = 0; b < 2; ++b)
#pragma unroll
            for (int m = 0; m < 4; ++m)
#pragma unroll
                for (int n = 0; n < 2; ++n) acc[a][b][m][n] = (f32x4){0.f, 0.f, 0.f, 0.f};
    bf16x8 At[4][2], B0[2][2], B1[2][2];
    const char* cA = (const char*)g.A + (size_t)cur.pm * tstep; const char* cB = (const char*)g.Bt + (size_t)cur.pn * tstep;
    S.a_ready(cur);
    if constexpr (SP2) {
        PG8_STAGE(PG8_SB(0, 0), cB, voffB); PG8_STAGE(PG8_SB(0, 1), cB + hstep, voffB); PG8_STAGE(PG8_SA(0, 0), cA, voffA); PG8_STAGE(PG8_SA(0, 1), cA + hstep, voffA);
        if (wr == 1) PG8_BAR;
        PG8_WAIT_V(2); PG8_BAR;
        PG8_STAGE(PG8_SB(1, 0), cB + kstep, voffB); PG8_STAGE(PG8_SA(1, 0), cA + kstep, voffA); PG8_STAGE(PG8_SB(1, 1), cB + hstep + kstep, voffB);
        PG8_WAIT_V(6); PG8_BAR;
    } else {
        PG8_STAGE(PG8_SB(0, 0), cB, voffB); PG8_STAGE(PG8_SA(0, 0), cA, voffA); PG8_STAGE(PG8_SB(0, 1), cB + hstep, voffB); PG8_STAGE(PG8_SA(0, 1), cA + hstep, voffA);
        if (wr == 1) PG8_BAR;
        PG8_WAIT_V(4); PG8_BAR;
        PG8_STAGE(PG8_SB(1, 0), cB + kstep, voffB); PG8_STAGE(PG8_SA(1, 0), cA + kstep, voffA); PG8_STAGE(PG8_SB(1, 1), cB + hstep + kstep, voffB);
        PG8_WAIT_V(6); PG8_BAR;
    }
    for (;;) {
        const bool has_next = S.next(ui + 1, nxt);
        const char* nA = has_next ? (const char*)g.A + (size_t)nxt.pm * tstep : cA; const char* nB = has_next ? (const char*)g.Bt + (size_t)nxt.pn * tstep : cB;
        for (int t = 0; t < nt; t += 2) {
            const bool last = (t == nt - 2);
            if (last) E.prefetch(epi_pre, cur, wr, fr);
            const char* a1 = cA + (size_t)(t + 1) * kstep;
            const char* a2 = last ? nA : cA + (size_t)(t + 2) * kstep; const char* b2 = last ? nB : cB + (size_t)(t + 2) * kstep;
            const char* a3 = a2 + kstep; const char* b3 = b2 + kstep;
            if (last && has_next) S.a_ready(nxt);
            if constexpr (SP2) {
            PG8_LDB(B0, 0, 0); PG8_LDB(B1, 0, 1); PG8_SCHED; PG8_LDA(At, 0, 0); PG8_STAGE(PG8_SA(1, 1), a1 + hstep, voffA);
            PG8_WAIT_V(8); PG8_WAIT_L(0); PG8_BAR; PG8_MMA(0, 0, At, B0); PG8_MMA(0, 1, At, B1); PG8_BAR; PG8_SCHED;
            PG8_LDA(At, 0, 1); PG8_STAGE(PG8_SB(0, 0), b2, voffB); PG8_STAGE(PG8_SB(0, 1), b2 + hstep, voffB); PG8_STAGE(PG8_SA(0, 0), a2, voffA);
            PG8_WAIT_V(8); PG8_WAIT_L(0); PG8_BAR; PG8_MMA(1, 0, At, B0); PG8_MMA(1, 1, At, B1); PG8_BAR; PG8_SCHED;
            PG8_LDB(B0, 1, 0); PG8_LDB(B1, 1, 1); PG8_SCHED; PG8_LDA(At, 1, 0); PG8_STAGE(PG8_SA(0, 1), a2 + hstep, voffA);
            PG8_WAIT_V(8); PG8_WAIT_L(0); PG8_BAR; PG8_MMA(0, 0, At, B0); PG8_MMA(0, 1, At, B1); PG8_BAR; PG8_SCHED;
            PG8_LDA(At, 1, 1); PG8_STAGE(PG8_SB(1, 0), b3, voffB); PG8_STAGE(PG8_SB(1, 1), b3 + hstep, voffB); PG8_STAGE(PG8_SA(1, 0), a3, voffA);
            PG8_WAIT_V(8); PG8_WAIT_L(0); PG8_BAR; PG8_MMA(1, 0, At, B0); PG8_MMA(1, 1, At, B1); PG8_BAR; PG8_SCHED;
            } else {
            PG8_LDB(B0, 0, 0); PG8_SCHED; PG8_LDA(At, 0, 0); PG8_STAGE(PG8_SA(1, 1), a1 + hstep, voffA);
            PG8_WAIT_L(8); PG8_BAR; PG8_WAIT_L(0); PG8_MMA(0, 0, At, B0); PG8_BAR; PG8_SCHED;
            PG8_LDB(B1, 0, 1); PG8_STAGE(PG8_SB(0, 0), b2, voffB);
            PG8_BAR; PG8_WAIT_L(0); PG8_MMA(0, 1, At, B1); PG8_BAR;
            PG8_LDA(At, 0, 1); PG8_STAGE(PG8_SA(0, 0), a2, voffA);
            PG8_BAR; PG8_WAIT_L(0); PG8_MMA(1, 0, At, B0); PG8_BAR; PG8_SCHED;
            PG8_STAGE(PG8_SB(0, 1), b2 + hstep, voffB);
            PG8_WAIT_V(6); PG8_BAR; PG8_MMA(1, 1, At, B1); PG8_BAR;
            PG8_LDB(B0, 1, 0); PG8_SCHED; PG8_LDA(At, 1, 0); PG8_STAGE(PG8_SA(0, 1), a2 + hstep, voffA);
            PG8_WAIT_L(8); PG8_BAR; PG8_WAIT_L(0); PG8_MMA(0, 0, At, B0); PG8_BAR; PG8_SCHED;
            PG8_LDB(B1, 1, 1); PG8_STAGE(PG8_SB(1, 0), b3, voffB);
            PG8_BAR; PG8_WAIT_L(0); PG8_MMA(0, 1, At, B1); PG8_BAR;
            PG8_LDA(At, 1, 1); PG8_STAGE(PG8_SA(1, 0), a3, voffA);
            PG8_BAR; PG8_WAIT_L(0); PG8_MMA(1, 0, At, B0); PG8_BAR; PG8_SCHED;
            PG8_STAGE(PG8_SB(1, 1), b3 + hstep, voffB);
            PG8_WAIT_V(6); PG8_BAR; PG8_MMA(1, 1, At, B1); PG8_BAR;
            }
        }
        if constexpr (ALIGN_EPI) { if (wr == 0) PG8_BAR; }
        if constexpr (!Epi::AFTER_DRAIN) { E(acc, cur, wr, wc, fr, fq, epi_pre); S.done(cur); }
        if (!has_next) break;
#pragma unroll
        for (int a = 0; a < 2; ++a)
#pragma unroll
            for (int b = 0; b < 2; ++b)
#pragma unroll
                for (int m = 0; m < 4; ++m)
#pragma unroll
                    for (int n = 0; n < 2; ++n) acc[a][b][m][n] = (f32x4){0.f, 0.f, 0.f, 0.f};
        cur = nxt; cA = nA; cB = nB; ++ui;
        if constexpr (ALIGN_EPI) { if (wr == 1) PG8_BAR; }
    }
    PG8_WAIT_V(0);
    if constexpr (!ALIGN_EPI) { if (wr == 0) PG8_BAR; }
    PG8_BAR;
    if constexpr (Epi::AFTER_DRAIN) { E.fused(acc, cur, wr, wc, fr, fq, lds, wid, lane); S.done(cur); }
#undef PG8_SA
#undef PG8_SB
#undef PG8_STAGE
#undef PG8_LDA
#undef PG8_LDB
#undef PG8_MMA
#undef PG8_WAIT_V
#undef PG8_WAIT_L
#undef PG8_BAR
#undef PG8_SCHED
}
}

#ifndef PG8_SP2
#define PG8_SP2 true
#endif
#ifndef PG8_ALIGN
#define PG8_ALIGN true
#endif
#ifndef MK_MULTI
#define MK_MULTI 0
#endif

constexpr int NWAVES = 8;
constexpr int BATCH = 32, SEQ = 2048, D = 1024, FF = 2816, NIN = 7168, NGU = 2 * FF;
constexpr int M = BATCH * SEQ;
constexpr int NH = 16, HD = 64, GW = 64, ROWS = SEQ / GW;
constexpr float EPS = 1e-6f;
constexpr float LOG2E = 1.4426950408889634f;

constexpr size_t MiB = 1u << 20;
constexpr size_t WS_SS0 = 0, WS_SS1 = 256 * 1024, WS_SS2 = 512 * 1024;
constexpr size_t WS_BAR = 768 * 1024;
constexpr size_t WS_WGU1 = 1 * MiB;
constexpr size_t WS_WDN1 = WS_WGU1 + (size_t)NGU * D * 2;
constexpr size_t WS_WIN  = WS_WDN1 + (size_t)D * FF * 2;
constexpr size_t WS_WOUT = WS_WIN + (size_t)NIN * D * 2;
constexpr size_t WS_WGU2 = WS_WOUT + (size_t)D * D * 2;
constexpr size_t WS_WDN2 = WS_WGU2 + (size_t)NGU * D * 2;
constexpr size_t WS_WG   = WS_WDN2 + (size_t)D * FF * 2;
constexpr size_t WS_HB   = 52 * MiB;
constexpr size_t ACT1    = (size_t)M * D * 2;
constexpr size_t WS_XR   = 180 * MiB;
constexpr size_t WS_GL   = WS_XR + ACT1, WS_Q = WS_GL + ACT1, WS_K = WS_Q + ACT1, WS_V = WS_K + ACT1, WS_GB = WS_V + ACT1;
constexpr size_t WS_ACT  = WS_XR;
constexpr size_t WS_END  = WS_GB + ACT1;
static_assert(WS_WG + 524288 <= WS_HB && WS_HB + ACT1 <= WS_XR && (size_t)M * FF * 2 <= 3 * ACT1, "d_ws map");

constexpr int LDS_BYTES = 147456;

#define LAS __attribute__((address_space(3)))
typedef unsigned short bf16;
typedef short bf16x8 __attribute__((ext_vector_type(8)));
typedef float f32x4 __attribute__((ext_vector_type(4)));
typedef unsigned u32x4 __attribute__((ext_vector_type(4)));
typedef unsigned u32x2 __attribute__((ext_vector_type(2)));

__device__ __forceinline__ float bf_lo(unsigned w) { return __uint_as_float(w << 16); }
__device__ __forceinline__ float bf_hi(unsigned w) { return __uint_as_float(w & 0xffff0000u); }
__device__ __forceinline__ unsigned pk2(float lo, float hi) { return pg8::cvt_pk_bf16(lo, hi); }
__device__ __forceinline__ float fexp2(float x) { return __builtin_amdgcn_exp2f(x); }
__device__ __forceinline__ float frcp(float x) { return __builtin_amdgcn_rcpf(x); }
__device__ __forceinline__ float sigm(float x) { return frcp(1.0f + fexp2(-x * LOG2E)); }
__device__ __forceinline__ float silu_f(float x) { return x * sigm(x); }
__device__ __forceinline__ float gelu_tanh(float x) {
    const float u2 = 1.5957691216057308f * (x + 0.044715f * x * x * x);
    return x * sigm(u2);
}
__device__ __forceinline__ float wave_sum(float v) {
#pragma unroll
    for (int o = 1; o < 64; o <<= 1) v += __shfl_xor(v, o);
    return v;
}

#define XB_TMO      128
#define XB_XCNT(j)  (256  + 64 * (j))
#define XB_XSUB(j)  (1280 + 64 * (j))
#define XB_XGEN(j)  (2304 + 64 * (j))
#define XB_TOP      3328
#define XB_TOPGEN   3392
#define XCD_BAR_WORDS 3456
#define XB_SPIN_CAP (1u << 18)

__device__ __forceinline__ unsigned xb_ld(unsigned* p)              { return __hip_atomic_load(p, __ATOMIC_RELAXED, __HIP_MEMORY_SCOPE_AGENT); }
__device__ __forceinline__ unsigned xb_add(unsigned* p, unsigned v) { return __hip_atomic_fetch_add(p, v, __ATOMIC_RELAXED, __HIP_MEMORY_SCOPE_AGENT); }
__device__ __forceinline__ unsigned xb_xcc_id() { return (unsigned)__builtin_amdgcn_s_getreg((3 << 11) | 20) & 0xFu; }
#define XB_SPIN(cond, bar) do { unsigned _sp = 0; while (cond) { __builtin_amdgcn_s_sleep(1); \
    if ((++_sp & 255u) == 0u) { if (xb_ld(&(bar)[XB_TMO])) break; if (_sp > XB_SPIN_CAP) { atomicAdd(&(bar)[XB_TMO], 1u); break; } } } } while (0)

struct XcdBarrier {
    unsigned* bar; unsigned x;
    volatile LAS unsigned* st;
};

__device__ __forceinline__ XcdBarrier xcd_barrier_post(unsigned* bar, volatile LAS unsigned* st) {
    XcdBarrier b; b.bar = bar; b.x = xb_xcc_id(); b.st = st;
    if (threadIdx.x == 0) (void)xb_add(&bar[XB_XCNT(b.x)], 1u);
    return b;
}
__device__ __forceinline__ void xcd_barrier_complete(unsigned* bar, unsigned x, unsigned& nloc, unsigned& nx) {
    const unsigned G = gridDim.x * gridDim.y * gridDim.z;
    unsigned sum, cnt, mine, sp = 0u;
    for (;;) {
        sum = 0u; cnt = 0u; mine = 0u;
#pragma unroll
        for (unsigned j = 0; j < 16; ++j) { const unsigned c = xb_ld(&bar[XB_XCNT(j)]); sum += c; cnt += (c > 0u) ? 1u : 0u; mine = (j == x) ? c : mine; }
        if (sum == G) break;
        __builtin_amdgcn_s_sleep(1);
        if ((++sp & 255u) == 0u) { if (xb_ld(&bar[XB_TMO])) break; if (sp > XB_SPIN_CAP) { atomicAdd(&bar[XB_TMO], 1u); break; } }
    }
    nloc = mine > 0u ? mine : 1u; nx = cnt > 0u ? cnt : 1u;
}

__device__ __forceinline__ void xcd_barrier(const XcdBarrier& b) {
    asm volatile("s_waitcnt vmcnt(0)" ::: "memory");
    __syncthreads();
    if (threadIdx.x == 0) {
        unsigned* bar = b.bar;
        __builtin_amdgcn_s_waitcnt(0);
        unsigned nloc = b.st[0], nx = b.st[1];
        if (nloc == 0u) { xcd_barrier_complete(bar, b.x, nloc, nx); b.st[0] = nloc; b.st[1] = nx; }
        const unsigned old = xb_add(&bar[XB_XSUB(b.x)], 1u);
        const unsigned gen = old / nloc;
        if (old + 1u == (gen + 1u) * nloc) {
            __builtin_amdgcn_fence(__ATOMIC_RELEASE, "agent");
            asm volatile("s_waitcnt vmcnt(0)" ::: "memory");
            const unsigned og = xb_add(&bar[XB_TOP], 1u);
            const unsigned tg = og / nx;
            if (og + 1u == (tg + 1u) * nx) xb_add(&bar[XB_TOPGEN], 1u);
            else XB_SPIN(xb_ld(&bar[XB_TOPGEN]) == tg, bar);
            __builtin_amdgcn_fence(__ATOMIC_ACQUIRE, "agent");
            xb_add(&bar[XB_XGEN(b.x)], 1u);
            asm volatile("s_waitcnt vmcnt(0)" ::: "memory");
        } else {
            XB_SPIN(xb_ld(&bar[XB_XGEN(b.x)]) == gen, bar);
            __builtin_amdgcn_fence(__ATOMIC_ACQUIRE, "agent");
            asm volatile("s_waitcnt vmcnt(0)" ::: "memory");
        }
    }
    __syncthreads();
}

namespace pg8 {
struct EpiGU {
    static constexpr bool PERM = true, AFTER_DRAIN = false;
    bf16_t* O; const float* SS;
    __device__ __forceinline__ void prefetch(float (&pre)[8], const Unit& u, int wr, int fr) const {
        const int row0 = u.pm * BM + wr * 64 + fr;
#pragma unroll
        for (int i = 0; i < 8; ++i) pre[i] = SS[row0 + (i >> 2) * HALF + (i & 3) * 16];
    }
    __device__ __forceinline__ void operator()(const f32x4 (&acc)[2][2][4][2], const Unit& u, int wr, int wc, int fr, int fq, const float (&pre)[8]) const {
        const int row0 = u.pm * BM + wr * 64 + fr, col0 = u.pn * 128 + wc * 32 + 8 * fq;
#pragma unroll
        for (int ai = 0; ai < 2; ++ai)
#pragma unroll
            for (int m = 0; m < 4; ++m) {
                const int row = row0 + ai * HALF + m * 16;
                const float rs = __builtin_amdgcn_rsqf(pre[ai * 4 + m] * (1.0f / D) + EPS);
                bf16_t* p = O + (size_t)row * FF + col0;
                const f32x4 g0 = acc[ai][0][m][0] * rs, g1 = acc[ai][0][m][1] * rs, u0 = acc[ai][1][m][0] * rs, u1 = acc[ai][1][m][1] * rs;
                u32x4 w;
                w.x = cvt_pk_bf16(silu_f(g0[0]) * u0[0], silu_f(g0[1]) * u0[1]); w.y = cvt_pk_bf16(silu_f(g0[2]) * u0[2], silu_f(g0[3]) * u0[3]);
                w.z = cvt_pk_bf16(silu_f(g1[0]) * u1[0], silu_f(g1[1]) * u1[1]); w.w = cvt_pk_bf16(silu_f(g1[2]) * u1[2], silu_f(g1[3]) * u1[3]);
                *(u32x4*)p = w;
            }
    }
};
template <bool LAST, bool HALFSCALE> struct EpiRes {
    static constexpr bool PERM = true, AFTER_DRAIN = false;
    bf16_t* XB; float* OUT; float* SS;
    static constexpr float scale = HALFSCALE ? 0.5f : 1.0f;
    __device__ __forceinline__ void prefetch(float (&)[8], const Unit&, int, int) const {}
    __device__ __forceinline__ void operator()(const f32x4 (&acc)[2][2][4][2], const Unit& u, int wr, int wc, int fr, int fq, const float (&)[8]) const {
        const int row0 = u.pm * BM + wr * 64 + fr, col0 = u.pn * BM + wc * 32 + 8 * fq;
#pragma unroll
        for (int ai = 0; ai < 2; ++ai) {
            u32x4 bs[4][2];
#pragma unroll
            for (int m = 0; m < 4; ++m) { const size_t off = (size_t)(row0 + ai * HALF + m * 16) * D + col0;
#pragma unroll
                for (int bj = 0; bj < 2; ++bj) bs[m][bj] = *(const u32x4*)(XB + off + bj * HALF); }
#pragma unroll
            for (int m = 0; m < 4; ++m) {
                const int row = row0 + ai * HALF + m * 16;
                const size_t off = (size_t)row * D + col0;
                float ss = 0.f;
#pragma unroll
                for (int bj = 0; bj < 2; ++bj) {
                    const u32x4 b = bs[m][bj];
                    const f32x4 b0 = {__uint_as_float(b.x << 16), __uint_as_float(b.x & 0xffff0000u), __uint_as_float(b.y << 16), __uint_as_float(b.y & 0xffff0000u)};
                    const f32x4 b1 = {__uint_as_float(b.z << 16), __uint_as_float(b.z & 0xffff0000u), __uint_as_float(b.w << 16), __uint_as_float(b.w & 0xffff0000u)};
                    const f32x4 v0 = b0 + acc[ai][bj][m][0] * scale, v1 = b1 + acc[ai][bj][m][1] * scale;
                    if (LAST) { *(f32x4*)(OUT + off + bj * HALF) = v0; *(f32x4*)(OUT + off + bj * HALF + 4) = v1; }
                    else {
                        u32x4 w; w.x = cvt_pk_bf16(v0[0], v0[1]); w.y = cvt_pk_bf16(v0[2], v0[3]); w.z = cvt_pk_bf16(v1[0], v1[1]); w.w = cvt_pk_bf16(v1[2], v1[3]);
                        *(u32x4*)(XB + off + bj * HALF) = w;
                        ss += (v0[0] * v0[0] + v0[1] * v0[1]) + (v0[2] * v0[2] + v0[3] * v0[3]) + (v1[0] * v1[0] + v1[1] * v1[1]) + (v1[2] * v1[2] + v1[3] * v1[3]);
                    }
                }
                if (!LAST) { ss += __shfl_xor(ss, 16); ss += __shfl_xor(ss, 32); if (fq == 0) atomicAdd(SS + row, ss); }
            }
            asm volatile("" ::: "memory");
        }
    }
};
struct EpiIn {
    static constexpr bool PERM = true, AFTER_DRAIN = false;
    bf16_t *XR, *GL, *Q, *K, *V, *GB; const float *qn, *kn; const float* SS;
    __device__ __forceinline__ void prefetch(float (&pre)[8], const Unit& u, int wr, int fr) const {
        const int row0 = u.pm * BM + wr * 64 + fr;
#pragma unroll
        for (int i = 0; i < 8; ++i) pre[i] = SS[row0 + (i >> 2) * HALF + (i & 3) * 16];
    }
    __device__ __forceinline__ void operator()(const f32x4 (&acc)[2][2][4][2], const Unit& u, int wr, int wc, int fr, int fq, const float (&pre)[8]) const {
        const int row0 = u.pm * BM + wr * 64 + fr, pn = u.pn;
        float rsv[8];
#pragma unroll
        for (int i = 0; i < 8; ++i) rsv[i] = __builtin_amdgcn_rsqf(pre[i] * (1.0f / D) + EPS);
        if (pn < 4 || (pn >= 20 && pn < 24)) {
            bf16_t* O = pn < 4 ? XR : V; const int col0 = (pn < 4 ? pn : pn - 20) * BM + wc * 32 + 8 * fq;
#pragma unroll
            for (int ai = 0; ai < 2; ++ai)
#pragma unroll
                for (int m = 0; m < 4; ++m) {
                    const float rs = rsv[ai * 4 + m];
                    bf16_t* p = O + (size_t)(row0 + ai * HALF + m * 16) * D + col0;
#pragma unroll
                    for (int bj = 0; bj < 2; ++bj) { const f32x4 v0 = acc[ai][bj][m][0] * rs, v1 = acc[ai][bj][m][1] * rs;
                        u32x4 w; w.x = cvt_pk_bf16(v0[0], v0[1]); w.y = cvt_pk_bf16(v0[2], v0[3]); w.z = cvt_pk_bf16(v1[0], v1[1]); w.w = cvt_pk_bf16(v1[2], v1[3]);
                        *(u32x4*)(p + bj * HALF) = w; }
                }
        } else if (pn >= 24) {
            const int col0 = (pn - 24) * BM + wc * 32 + 8 * fq;
#pragma unroll
            for (int ai = 0; ai < 2; ++ai)
#pragma unroll
                for (int m = 0; m < 4; ++m) {
                    const float rn = rsv[ai * 4 + m] * (-LOG2E);
                    bf16_t* p = GB + (size_t)(row0 + ai * HALF + m * 16) * D + col0;
#define SG1(X) frcp(1.0f + fexp2((X) * rn))
#pragma unroll
                    for (int bj = 0; bj < 2; ++bj) { const f32x4 v0 = acc[ai][bj][m][0], v1 = acc[ai][bj][m][1];
                        u32x4 w; w.x = cvt_pk_bf16(SG1(v0[0]), SG1(v0[1])); w.y = cvt_pk_bf16(SG1(v0[2]), SG1(v0[3])); w.z = cvt_pk_bf16(SG1(v1[0]), SG1(v1[1])); w.w = cvt_pk_bf16(SG1(v1[2]), SG1(v1[3]));
                        *(u32x4*)(p + bj * HALF) = w; }
#undef SG1
                }
        } else if (pn < 12) {
            const int col0 = (pn - 4) * 128 + wc * 32 + 8 * fq;
#pragma unroll
            for (int ai = 0; ai < 2; ++ai)
#pragma unroll
                for (int m = 0; m < 4; ++m) {
                    const float rs = rsv[ai * 4 + m], rn = rs * (-LOG2E);
                    bf16_t* p = GL + (size_t)(row0 + ai * HALF + m * 16) * D + col0;
                    const f32x4 g0 = acc[ai][0][m][0] * rs, g1 = acc[ai][0][m][1] * rs, a0 = acc[ai][1][m][0], a1 = acc[ai][1][m][1];
#define GLF(X, A) ((X) * frcp((1.0f + fexp2((-1.5957691216057308f * LOG2E) * ((X) + 0.044715f * (X) * (X) * (X)))) * (1.0f + fexp2((A) * rn))))
                    u32x4 w;
                    w.x = cvt_pk_bf16(GLF(g0[0], a0[0]), GLF(g0[1], a0[1])); w.y = cvt_pk_bf16(GLF(g0[2], a0[2]), GLF(g0[3], a0[3]));
                    w.z = cvt_pk_bf16(GLF(g1[0], a1[0]), GLF(g1[1], a1[1])); w.w = cvt_pk_bf16(GLF(g1[2], a1[2]), GLF(g1[3], a1[3]));
#undef GLF
                    *(u32x4*)p = w;
                }
        } else {
            const bool isq = pn < 16; bf16_t* O = isq ? Q : K; const float* nw = isq ? qn : kn; const float sc = isq ? 0.125f * LOG2E : 1.0f;
            const int head = 4 * (pn - (isq ? 12 : 16)) + wc;
            f32x4 nv[2][2];
#pragma unroll
            for (int bj = 0; bj < 2; ++bj)
#pragma unroll
                for (int n = 0; n < 2; ++n) nv[bj][n] = *(const f32x4*)(nw + 32 * bj + 8 * fq + 4 * n) * sc;
#pragma unroll
            for (int ai = 0; ai < 2; ++ai)
#pragma unroll
                for (int m = 0; m < 4; ++m) {
                    float ss = 0.f;
#pragma unroll
                    for (int bj = 0; bj < 2; ++bj)
#pragma unroll
                        for (int n = 0; n < 2; ++n) { const f32x4 x = acc[ai][bj][m][n]; ss += (x[0] * x[0] + x[1] * x[1]) + (x[2] * x[2] + x[3] * x[3]); }
                    ss += __shfl_xor(ss, 16); ss += __shfl_xor(ss, 32);
                    const float r0 = rsv[ai * 4 + m];
                    const float rs = __builtin_amdgcn_rsqf(ss * (r0 * r0) * (1.0f / 64.0f) + EPS) * r0;
                    bf16_t* p = O + (size_t)(row0 + ai * HALF + m * 16) * D + head * 64 + 8 * fq;
#pragma unroll
                    for (int bj = 0; bj < 2; ++bj) { const f32x4 v0 = acc[ai][bj][m][0] * (nv[bj][0] * rs), v1 = acc[ai][bj][m][1] * (nv[bj][1] * rs);
                        u32x4 w; w.x = cvt_pk_bf16(v0[0], v0[1]); w.y = cvt_pk_bf16(v0[2], v0[3]); w.z = cvt_pk_bf16(v1[0], v1[1]); w.w = cvt_pk_bf16(v1[2], v1[3]);
                        *(u32x4*)(p + 32 * bj) = w; }
                }
        }
    }
};
}

struct Frame {
    LAS unsigned char* lds;
    int tid, lane, wave, vcu, G;
    const float* in[18]; float* out; unsigned char* ws;
};

__device__ __forceinline__ int map_gu(int n) { const int pn = n >> 8, bj = (n >> 7) & 1, i = n & 127; return bj * FF + 128 * pn + i; }
__device__ __forceinline__ int map_in(int n) {
    const int pn = n >> 8, rem = n & 255, bj = rem >> 7, wcw = (rem >> 5) & 3, i = rem & 31;
    if (pn < 4) return n;
    if (pn < 12) return (bj ? 5120 : 1024) + 128 * (pn - 4) + (rem & 127);
    if (pn < 16) return 2048 + 64 * (4 * (pn - 12) + wcw) + 32 * bj + i;
    if (pn < 20) return 3072 + 64 * (4 * (pn - 16) + wcw) + 32 * bj + i;
    if (pn < 24) return 4096 + 256 * (pn - 20) + rem;
    return 6144 + 256 * (pn - 24) + rem;
}
__device__ __forceinline__ void transpose_item(const float* W, int K, int N, int k0, int src_n0, bf16* WT, int dst_row0, LAS float* scr, int lane, const float* gk = nullptr, const float mul = 1.0f) {
#pragma unroll 8
    for (int i = 0; i < 32; ++i) { const int kk = 2 * i + (lane >> 5); const float sc = gk ? gk[k0 + kk] : mul; scr[kk * 33 + (lane & 31)] = W[(size_t)(k0 + kk) * N + src_n0 + (lane & 31)] * sc; }
    asm volatile("s_waitcnt lgkmcnt(0)" ::: "memory");
    const int c = lane & 7;
#pragma unroll
    for (int j = 0; j < 4; ++j) { const int n = (lane >> 3) + 8 * j; const LAS float* s = scr + (8 * c) * 33 + n;
        u32x4 o; o.x = pk2(s[0 * 33], s[1 * 33]); o.y = pk2(s[2 * 33], s[3 * 33]); o.z = pk2(s[4 * 33], s[5 * 33]); o.w = pk2(s[6 * 33], s[7 * 33]);
        *(u32x4*)(WT + (size_t)(dst_row0 + n) * K + k0 + 8 * c) = o; }
    asm volatile("s_waitcnt lgkmcnt(0)" ::: "memory");
}
__device__ __forceinline__ void convert_rows(Frame& F, const float* X, bf16* O, float* SS) {
    const int gw = F.vcu * NWAVES + F.wave, NGW = F.G * NWAVES;
    for (int m = gw; m < M; m += NGW) {
        const f32x4* xr = (const f32x4*)(X + (size_t)m * D) + F.lane;
        f32x4 v[4]; float s = 0.f;
#pragma unroll
        for (int j = 0; j < 4; ++j) { v[j] = xr[64 * j]; s += (v[j].x * v[j].x + v[j].y * v[j].y) + (v[j].z * v[j].z + v[j].w * v[j].w); }
        s = wave_sum(s);
        u32x2* o8 = (u32x2*)(O + (size_t)m * D) + F.lane;
#pragma unroll
        for (int j = 0; j < 4; ++j) { u32x2 w; w.x = pk2(v[j].x, v[j].y); w.y = pk2(v[j].z, v[j].w); o8[64 * j] = w; }
        if (F.lane == 0) SS[m] = s;
    }
}

__device__ __forceinline__ void p0_prologue(Frame& F) {
    LAS float* scr = (LAS float*)(F.lds + F.wave * 16384);
    const int gw = F.vcu * NWAVES + F.wave, NGW = F.G * NWAVES;
    constexpr int I_GU = (D / 64) * (NGU / 32), I_DN = (FF / 64) * (D / 32), I_IN = (D / 64) * (NIN / 32), I_OUT = (D / 64) * (D / 32), I_G = 64 * 2;
    constexpr int NITEMS = 2 * I_GU + 2 * I_DN + I_IN + I_OUT + I_G;
    for (int it = gw; it < NITEMS; it += NGW) {
        int r = it;
        if (r < 2 * I_GU) { const int which = r >= I_GU; r -= which * I_GU; const int nblk = NGU / 32, kb = r / nblk, nb = r % nblk;
            transpose_item(F.in[which ? 16 : 2], D, NGU, 64 * kb, map_gu(32 * nb), (bf16*)(F.ws + (which ? WS_WGU2 : WS_WGU1)), 32 * nb, scr, F.lane, F.in[which ? 15 : 1]); continue; }
        r -= 2 * I_GU;
        if (r < 2 * I_DN) { const int which = r >= I_DN; r -= which * I_DN; const int nblk = D / 32, kb = r / nblk, nb = r % nblk;
            transpose_item(F.in[which ? 17 : 3], FF, D, 64 * kb, 32 * nb, (bf16*)(F.ws + (which ? WS_WDN2 : WS_WDN1)), 32 * nb, scr, F.lane); continue; }
        r -= 2 * I_DN;
        if (r < I_IN) { const int nblk = NIN / 32, kb = r / nblk, nb = r % nblk;
            transpose_item(F.in[5], D, NIN, 64 * kb, map_in(32 * nb), (bf16*)(F.ws + WS_WIN), 32 * nb, scr, F.lane, F.in[4]); continue; }
        r -= I_IN;
        if (r < I_OUT) { const int nblk = D / 32, kb = r / nblk, nb = r % nblk;
            transpose_item(F.in[14], D, D, 64 * kb, 32 * nb, (bf16*)(F.ws + WS_WOUT), 32 * nb, scr, F.lane); continue; }
        r -= I_OUT;
        { const int mat = r >> 1, nb = r & 1;
          transpose_item(F.in[8] + (size_t)mat * 4096, 64, 64, 0, 32 * nb, (bf16*)(F.ws + WS_WG) + (size_t)mat * 4096, 32 * nb, scr, F.lane, nullptr, -LOG2E); }
    }
    { float* z = (float*)(F.ws + WS_SS1); for (int i = (int)blockIdx.x * (NWAVES * 64) + F.tid; i < 2 * M; i += F.G * NWAVES * 64) z[i] = 0.f; }
    convert_rows(F, F.in[0], (bf16*)(F.ws + WS_HB), (float*)(F.ws + WS_SS0));
}

__device__ __forceinline__ void scan_phase(Frame& F) {
    const int tid = F.tid, lane = F.lane, w = F.wave, fr = lane & 15, fq = lane >> 4;
    constexpr int XC_B = 34816, XCB_B = 18432;
    LAS unsigned short* XCB = (LAS unsigned short*)(F.lds + 2 * XC_B);
    LAS float* AA = (LAS float*)(F.lds + 2 * XC_B + XCB_B);
    LAS float* AGG = (LAS float*)(F.lds + 3 * XC_B + XCB_B);
    LAS float* CAR = (LAS float*)(F.lds + 3 * XC_B + XCB_B + 4096);
    LAS float* CWL = (LAS float*)(F.lds + 3 * XC_B + XCB_B + 4096 + 512);
    LAS bf16x8* WFL = (LAS bf16x8*)(F.lds + 3 * XC_B + XCB_B + 4096 + 512 + 1280);
    static_assert(3 * XC_B + XCB_B + 4096 + 512 + 1280 + 16384 <= LDS_BYTES, "scan LDS map");
    const bf16* XR = (const bf16*)(F.ws + WS_XR); bf16* GL = (bf16*)(F.ws + WS_GL); bf16* HF = (bf16*)F.out;
    const bf16* WG = (const bf16*)(F.ws + WS_WG);
    const float* conv_w = F.in[6]; const float* conv_b = F.in[7]; const float* bg = F.in[9]; const float* lam = F.in[10];
    const int c = tid & 7, tokb = tid >> 3;
    for (int u = blockIdx.x; u < BATCH * 16; u += F.G) {
        const int b = u >> 4, n = u & 15, chb = n * 64; const size_t rowbase = (size_t)b * SEQ;
        __syncthreads();
        if (tid < 256) CWL[tid] = conv_w[(tid >> 6) * D + chb + (tid & 63)]; else if (tid < 320) CWL[tid] = conv_b[chb + (tid & 63)];
        const bf16* xrp = XR + rowbase * D + chb + 8 * c;
        for (int dir = 0; dir < 2; ++dir) {
            float br[4], bi[4], c8[4];
            __syncthreads();
#pragma unroll
            for (int q = 0; q < 2; ++q) { const int idx = 2 * w + q, g = idx >> 3, ct = (idx >> 1) & 3, ks = idx & 1;
                WFL[idx * 64 + lane] = *(const bf16x8*)(WG + ((size_t)((dir * 2 + g) * 16 + n) * 64 + 16 * ct + fr) * 64 + 8 * fq + 32 * ks); }
#pragma unroll
            for (int ct = 0; ct < 4; ++ct) { const int ch = chb + 16 * ct + fr;
                br[ct] = bg[(dir * 2 + 0) * D + ch] * (-LOG2E); bi[ct] = bg[(dir * 2 + 1) * D + ch] * (-LOG2E);
                const float l = lam[dir * D + ch]; const float sp = fmaxf(-l, 0.f) + log1pf(__expf(-fabsf(l)));
                c8[ct] = 8.0f * sp * LOG2E; }
            if (tid < 64) CAR[tid] = 0.f;
            u32x4 xv[5];
#define SCAN_LOADX(T0) do { _Pragma("unroll") for (int k = 0; k < 5; ++k) { const int tt = (T0) + 2 * tokb + k - 2; \
                xv[k] = (tt >= 0 && tt < SEQ) ? *(const u32x4*)(xrp + (size_t)tt * D) : (u32x4){0u, 0u, 0u, 0u}; } } while (0)
            SCAN_LOADX(dir == 0 ? 0 : SEQ - 128);
            __syncthreads();
            for (int tile = 0; tile < SEQ / 128; ++tile) {
                const int t0 = (dir == 0 ? tile : (SEQ / 128 - 1 - tile)) * 128, pb = tile & 1;
                LAS float* XC = (LAS float*)(F.lds + pb * XC_B);
#pragma unroll
                for (int it = 0; it < 2; ++it) {
                    const int tok = 2 * tokb + it;
                    float a8[8];
                    { const f32x4 b0 = *(const LAS f32x4*)(CWL + 256 + 8 * c), b1 = *(const LAS f32x4*)(CWL + 256 + 8 * c + 4);
                      a8[0] = b0[0]; a8[1] = b0[1]; a8[2] = b0[2]; a8[3] = b0[3]; a8[4] = b1[0]; a8[5] = b1[1]; a8[6] = b1[2]; a8[7] = b1[3]; }
#pragma unroll
                    for (int k = 0; k < 4; ++k) { const u32x4 v = xv[it + k];
                        const f32x4 w0 = *(const LAS f32x4*)(CWL + 64 * k + 8 * c), w1 = *(const LAS f32x4*)(CWL + 64 * k + 8 * c + 4);
                        a8[0] += w0[0] * bf_lo(v[0]); a8[1] += w0[1] * bf_hi(v[0]); a8[2] += w0[2] * bf_lo(v[1]); a8[3] += w0[3] * bf_hi(v[1]);
                        a8[4] += w1[0] * bf_lo(v[2]); a8[5] += w1[1] * bf_hi(v[2]); a8[6] += w1[2] * bf_lo(v[3]); a8[7] += w1[3] * bf_hi(v[3]); }
                    *(LAS f32x4*)(XC + tok * 68 + 8 * c) = (f32x4){a8[0], a8[1], a8[2], a8[3]};
                    *(LAS f32x4*)(XC + tok * 68 + 8 * c + 4) = (f32x4){a8[4], a8[5], a8[6], a8[7]};
                    u32x4 pw; pw.x = pk2(a8[0], a8[1]); pw.y = pk2(a8[2], a8[3]); pw.z = pk2(a8[4], a8[5]); pw.w = pk2(a8[6], a8[7]);
                    *(LAS u32x4*)(XCB + tok * 72 + 8 * c) = pw;
                }
                if (tile + 1 < SEQ / 128) SCAN_LOADX(dir == 0 ? t0 + 128 : t0 - 128);
                __syncthreads();
                {
                    const bf16x8 a0 = *(const LAS bf16x8*)(XCB + (16 * w + fr) * 72 + 8 * fq), a1 = *(const LAS bf16x8*)(XCB + (16 * w + fr) * 72 + 8 * fq + 32);
#pragma unroll
                    for (int ct = 0; ct < 4; ++ct) {
                        f32x4 gr = {br[ct], br[ct], br[ct], br[ct]}, gi = {bi[ct], bi[ct], bi[ct], bi[ct]};
                        gr = __builtin_amdgcn_mfma_f32_16x16x32_bf16(a0, WFL[(ct * 2 + 0) * 64 + lane], gr, 0, 0, 0); gr = __builtin_amdgcn_mfma_f32_16x16x32_bf16(a1, WFL[(ct * 2 + 1) * 64 + lane], gr, 0, 0, 0);
                        gi = __builtin_amdgcn_mfma_f32_16x16x32_bf16(a0, WFL[(8 + ct * 2 + 0) * 64 + lane], gi, 0, 0, 0); gi = __builtin_amdgcn_mfma_f32_16x16x32_bf16(a1, WFL[(8 + ct * 2 + 1) * 64 + lane], gi, 0, 0, 0);
#pragma unroll
                        for (int jj = 0; jj < 4; ++jj) { const int idx = (16 * w + 4 * fq + jj) * 68 + 16 * ct + fr;
                            const float xc = XC[idx]; const float r = frcp(1.0f + fexp2(gr[jj])), ig = frcp(1.0f + fexp2(gi[jj]));
                            const float a = fexp2(-c8[ct] * r); const float bx = __builtin_amdgcn_sqrtf(1.0f - a * a) * (ig * xc);
                            AA[idx] = a; XC[idx] = bx; }
                    }
                }
                u32x4 hfv[2], glv[2];
                if (dir == 1) {
#pragma unroll
                    for (int it = 0; it < 2; ++it) { const size_t g = (rowbase + t0 + 2 * tokb + it) * D + chb + 8 * c; hfv[it] = *(const u32x4*)(HF + g); glv[it] = *(const u32x4*)(GL + g); }
                }
                __syncthreads();
                {
                    float h = 0.f, P = 1.f;
#pragma unroll
                    for (int k = 0; k < 16; ++k) { const int tk = dir == 0 ? 16 * w + k : 16 * w + 15 - k; const float a = AA[tk * 68 + lane], bx = XC[tk * 68 + lane]; h = a * h + bx; P *= a; }
                    AGG[(w * 64 + lane) * 2] = P; AGG[(w * 64 + lane) * 2 + 1] = h;
                }
                __syncthreads();
                {
                    const int cur = tile & 1; float h = CAR[cur * 64 + lane];
                    if (dir == 0) { for (int s2 = 0; s2 < w; ++s2) h = AGG[(s2 * 64 + lane) * 2] * h + AGG[(s2 * 64 + lane) * 2 + 1]; }
                    else { for (int s2 = 7; s2 > w; --s2) h = AGG[(s2 * 64 + lane) * 2] * h + AGG[(s2 * 64 + lane) * 2 + 1]; }
#pragma unroll
                    for (int k = 0; k < 16; ++k) { const int tk = dir == 0 ? 16 * w + k : 16 * w + 15 - k; const float a = AA[tk * 68 + lane], bx = XC[tk * 68 + lane]; h = a * h + bx; XC[tk * 68 + lane] = h; }
                    if (w == (dir == 0 ? 7 : 0)) CAR[(cur ^ 1) * 64 + lane] = h;
                }
                __syncthreads();
#pragma unroll
                for (int it = 0; it < 2; ++it) {
                    const int tok = 2 * tokb + it;
                    const f32x4 h0 = *(const LAS f32x4*)(XC + tok * 68 + 8 * c), h1 = *(const LAS f32x4*)(XC + tok * 68 + 8 * c + 4);
                    const size_t g = (rowbase + t0 + tok) * D + chb + 8 * c;
                    if (dir == 0) { u32x4 pw; pw.x = pk2(h0[0], h0[1]); pw.y = pk2(h0[2], h0[3]); pw.z = pk2(h1[0], h1[1]); pw.w = pk2(h1[2], h1[3]); *(u32x4*)(HF + g) = pw; }
                    else { const u32x4 hf = hfv[it], gl = glv[it]; u32x4 pw;
                        pw.x = pk2(bf_lo(gl.x) * (bf_lo(hf.x) + h0[0]), bf_hi(gl.x) * (bf_hi(hf.x) + h0[1])); pw.y = pk2(bf_lo(gl.y) * (bf_lo(hf.y) + h0[2]), bf_hi(gl.y) * (bf_hi(hf.y) + h0[3]));
                        pw.z = pk2(bf_lo(gl.z) * (bf_lo(hf.z) + h1[0]), bf_hi(gl.z) * (bf_hi(hf.z) + h1[1])); pw.w = pk2(bf_lo(gl.w) * (bf_lo(hf.w) + h1[2]), bf_hi(gl.w) * (bf_hi(hf.w) + h1[3]));
                        *(u32x4*)(GL + g) = pw; }
                }
            }
            __syncthreads();
#undef SCAN_LOADX
        }
    }
}

__device__ __forceinline__ void attn_phase(Frame& F) {
    const int tid = F.tid, lane = F.lane, w = F.wave, fr = lane & 15, fq = lane >> 4;
    constexpr int VS = 488, VT_B = 64 * VS * 2, TAB_B = 4096, TAB_MASK = 512;
    static_assert(2 * VT_B + 2 * TAB_B <= LDS_BYTES, "attention LDS map");
    const bf16* Qb = (const bf16*)(F.ws + WS_Q); const bf16* Kb = (const bf16*)(F.ws + WS_K); const bf16* Vb = (const bf16*)(F.ws + WS_V);
    const bf16* GB = (const bf16*)(F.ws + WS_GB); bf16* Y = (bf16*)(F.ws + WS_GL);
    const float* rpb = F.in[13];
    constexpr int NU = BATCH * NH * 4 * 4;
    const bool contig = (NU % F.G) == 0; const int nun = contig ? NU / F.G : (NU - (int)blockIdx.x + F.G - 1) / F.G;
#define ATT_UNIT(i) (contig ? F.vcu * nun + (i) : (int)blockIdx.x + (i) * F.G)
    float SHIFT;
    { float mq = fabsf(F.in[11][lane]), mk = fabsf(F.in[12][lane]);
#pragma unroll
      for (int o = 1; o < 64; o <<= 1) { mq = fmaxf(mq, __shfl_xor(mq, o)); mk = fmaxf(mk, __shfl_xor(mk, o)); }
      SHIFT = 8.0f * LOG2E * 1.02f * mq * mk; }
    u32x4 nv[8]; float tabv = 0.f;
#define ATT_GEOM(u_, rg_, nb_, h_, b_, rmin_, nkeys_, kstart_) const int rg_ = (u_) & 3, nb_ = ((u_) >> 2) & 3, h_ = ((u_) >> 4) & 15, b_ = (u_) >> 8; \
        const int rmin_ = min(max(8 * rg_ - 4, 0), ROWS - 8), nkeys_ = (min(max(8 * rg_ + 3, 0), ROWS - 8) + 8 - rmin_) * 32, kstart_ = min(max(nb_ * 16 - 8, 0), GW - 32);
#define ATT_LOADV(u_) do { ATT_GEOM(u_, rg_, nb_, h_, b_, rmin_, nkeys_, kstart_) (void)rg_; \
        _Pragma("unroll") for (int it = 0; it < 8; ++it) { const int id = it * 512 + tid, cc = id / 480, key = id - cc * 480; \
            nv[it] = (id < 3840 && key < nkeys_) ? *(const u32x4*)(Vb + ((size_t)b_ * SEQ + (rmin_ + (key >> 5)) * GW + kstart_ + (key & 31)) * D + h_ * HD + 8 * cc) : (u32x4){0u, 0u, 0u, 0u}; } \
        tabv = tid < 465 ? rpb[h_ * 465 + tid] * LOG2E - SHIFT : -1e30f; } while (0)
#define ATT_WRITEV(u_, buf_) do { ATT_GEOM(u_, rg_, nb_, h_, b_, rmin_, nkeys_, kstart_) (void)rg_; (void)nb_; (void)h_; (void)b_; (void)rmin_; (void)kstart_; \
        LAS unsigned short* VTw = (LAS unsigned short*)(F.lds + (buf_) * VT_B); \
        _Pragma("unroll") for (int it = 0; it < 8; ++it) { const int id = it * 512 + tid, cc = id / 480, key = id - cc * 480; \
            if (id < 3840 && key < nkeys_) { _Pragma("unroll") for (int e = 0; e < 4; ++e) { VTw[(8 * cc + 2 * e) * VS + key] = (unsigned short)(nv[it][e] & 0xffffu); VTw[(8 * cc + 2 * e + 1) * VS + key] = (unsigned short)(nv[it][e] >> 16); } } } \
        { LAS float* tw_ = (LAS float*)(F.lds + 2 * VT_B + (buf_) * TAB_B); tw_[tid] = tabv; tw_[512 + tid] = -1e30f; } } while (0)
    bf16x8 qpre[2], kpre[8];
#define ATT_LOADQK(u_) do { ATT_GEOM(u_, rg_, nb_, h_, b_, rmin_, nkeys_, kstart_) (void)rmin_; (void)nkeys_; \
        const int r_ = 8 * rg_ + w, rs_ = min(max(r_ - 4, 0), ROWS - 8); const size_t rb_ = (size_t)b_ * SEQ; \
        const bf16* qp_ = Qb + (rb_ + r_ * GW + nb_ * 16 + fr) * D + h_ * HD + 8 * fq; qpre[0] = *(const bf16x8*)qp_; qpre[1] = *(const bf16x8*)(qp_ + 32); \
        _Pragma("unroll") for (int nt = 0; nt < 4; ++nt) { const bf16* kp_ = Kb + (rb_ + (rs_ + (nt >> 1)) * GW + kstart_ + (nt & 1) * 16 + fr) * D + h_ * HD + 8 * fq; \
            kpre[2 * nt] = *(const bf16x8*)kp_; kpre[2 * nt + 1] = *(const bf16x8*)(kp_ + 32); } } while (0)
    if (nun > 0) { const int u0 = ATT_UNIT(0); ATT_LOADV(u0); ATT_LOADQK(u0); ATT_WRITEV(u0, 0); }
    __syncthreads();
    for (int i = 0; i < nun; ++i) {
        const int u = ATT_UNIT(i), cur = i & 1;
        const LAS unsigned short* VT = (const LAS unsigned short*)(F.lds + cur * VT_B);
        const LAS float* TAB = (const LAS float*)(F.lds + 2 * VT_B + cur * TAB_B);
        ATT_GEOM(u, rg, nb, h, b, rmin, nkeys, kstart) (void)nkeys;
        const size_t rowbase = (size_t)b * SEQ;
        if (i + 1 < nun) { const int un = ATT_UNIT(i + 1); ATT_LOADV(un); }
        {
            const int r = 8 * rg + w, rs = min(max(r - 4, 0), ROWS - 8), koff = (rs - rmin) * 32;
            const int qc = nb * 16 + fr, cs = min(max(qc - 8, 0), GW - 16);
            const bf16x8 qf0 = qpre[0], qf1 = qpre[1];
            const size_t g0 = (rowbase + r * GW + qc) * D + h * HD + 4 * fq;
            u32x2 yv[4], gv[4];
#pragma unroll
            for (int dt = 0; dt < 4; ++dt) { yv[dt] = *(const u32x2*)(Y + g0 + 16 * dt); gv[dt] = *(const u32x2*)(GB + g0 + 16 * dt); }
            int dcx[8];
#pragma unroll
            for (int e = 0; e < 8; ++e) { const int kc = kstart + (e >> 2) * 16 + 4 * fq + (e & 3); dcx[e] = ((kc >= cs) && (kc < cs + 16)) ? min(max(kc - qc, -15), 15) + 15 + (rs - r + 7) * 31 : TAB_MASK; }
            f32x4 st[16];
#pragma unroll
            for (int nt = 0; nt < 16; ++nt) {
                bf16x8 kf0, kf1;
                if (nt < 4) { kf0 = kpre[2 * nt]; kf1 = kpre[2 * nt + 1]; }
                else { const int token = (rs + (nt >> 1)) * GW + kstart + (nt & 1) * 16 + fr;
                    const bf16* kp = Kb + (rowbase + token) * D + h * HD + 8 * fq;
                    kf0 = *(const bf16x8*)kp; kf1 = *(const bf16x8*)(kp + 32); }
                f32x4 z;
#pragma unroll
                for (int jj = 0; jj < 4; ++jj) z[jj] = TAB[(nt >> 1) * 31 + dcx[(nt & 1) * 4 + jj]];
                z = __builtin_amdgcn_mfma_f32_16x16x32_bf16(kf0, qf0, z, 0, 0, 0);
                st[nt] = __builtin_amdgcn_mfma_f32_16x16x32_bf16(kf1, qf1, z, 0, 0, 0);
            }
            float l = 0.f;
#pragma unroll
            for (int nt = 0; nt < 16; ++nt)
#pragma unroll
                for (int jj = 0; jj < 4; ++jj) { const float p = fexp2(st[nt][jj]); st[nt][jj] = p; l += p; }
            l += __shfl_xor(l, 16); l += __shfl_xor(l, 32);
            bf16x8 pb[8];
#pragma unroll
            for (int ks = 0; ks < 8; ++ks) { u32x4 pw; pw.x = pk2(st[2 * ks][0], st[2 * ks][1]); pw.y = pk2(st[2 * ks][2], st[2 * ks][3]); pw.z = pk2(st[2 * ks + 1][0], st[2 * ks + 1][1]); pw.w = pk2(st[2 * ks + 1][2], st[2 * ks + 1][3]);
                pb[ks] = __builtin_bit_cast(bf16x8, pw); }
            f32x4 o[4];
#pragma unroll
            for (int dt = 0; dt < 4; ++dt) { o[dt] = (f32x4){0.f, 0.f, 0.f, 0.f};
#pragma unroll
                for (int ks = 0; ks < 8; ++ks) { const LAS unsigned short* vp = VT + (16 * dt + fr) * VS + koff + 32 * ks + 4 * fq;
                    const u32x2 lo = *(const LAS u32x2*)vp, hi = *(const LAS u32x2*)(vp + 16);
                    const u32x4 av = {lo.x, lo.y, hi.x, hi.y};
                    o[dt] = __builtin_amdgcn_mfma_f32_16x16x32_bf16(__builtin_bit_cast(bf16x8, av), pb[ks], o[dt], 0, 0, 0); } }
            const float inv = frcp(l);
#pragma unroll
            for (int dt = 0; dt < 4; ++dt) { const size_t g = g0 + 16 * dt; u32x2 ov;
                ov.x = pk2(bf_lo(yv[dt].x) + bf_lo(gv[dt].x) * o[dt][0] * inv, bf_hi(yv[dt].x) + bf_hi(gv[dt].x) * o[dt][1] * inv);
                ov.y = pk2(bf_lo(yv[dt].y) + bf_lo(gv[dt].y) * o[dt][2] * inv, bf_hi(yv[dt].y) + bf_hi(gv[dt].y) * o[dt][3] * inv);
                *(u32x2*)(Y + g) = ov; }
        }
        if (i + 1 < nun) { const int un = ATT_UNIT(i + 1); ATT_LOADQK(un); ATT_WRITEV(un, cur ^ 1); }
        __syncthreads();
    }
#undef ATT_UNIT
#undef ATT_GEOM
#undef ATT_LOADV
#undef ATT_LOADQK
#undef ATT_WRITEV
}

struct Args { const float* in[18]; float* out; unsigned char* ws; int ph_lo, ph_hi, coop, pad; };
constexpr int N_PHASES = 9;
__global__ void __launch_bounds__(NWAVES * 64, 2) mk_fwd(Args args) {
    extern __shared__ __attribute__((aligned(16))) unsigned char lds[];
    Frame F;
    F.lds = (LAS unsigned char*)lds;
    F.tid = threadIdx.x; F.lane = F.tid & 63; F.wave = __builtin_amdgcn_readfirstlane(F.tid >> 6);
    F.G = gridDim.x; { const int bx = blockIdx.x; F.vcu = (F.G % 8 == 0) ? (bx % 8) * (F.G / 8) + bx / 8 : bx; }
#pragma unroll
    for (int i = 0; i < 18; ++i) F.in[i] = args.in[i];
    F.out = args.out; F.ws = args.ws;
    unsigned char* ws = args.ws;
    const int lo = args.ph_lo, hi = args.ph_hi; const bool coop = args.coop != 0;
#define IN(k) (lo <= (k) && (k) < hi)
    volatile LAS unsigned* MISC = (volatile LAS unsigned*)(F.lds + LDS_BYTES - 16);
    if (F.tid < 4) MISC[F.tid] = 0u;
    if (coop && lo == 0 && blockIdx.x == 0) { unsigned* bw = (unsigned*)(ws + WS_BAR); for (int i = F.tid; i < XCD_BAR_WORDS; i += NWAVES * 64) bw[i] = 0u; }
    __syncthreads();
    XcdBarrier bar; bar.bar = (unsigned*)(ws + WS_BAR); bar.x = 0; bar.st = MISC;
#define SEAM(k) do { if (coop && IN(k) && IN((k) + 1)) { if ((k) == 0) { cg::this_grid().sync(); bar = xcd_barrier_post((unsigned*)(ws + WS_BAR), MISC); } else { xcd_barrier(bar); } } } while (0)
    bf16* HB = (bf16*)(ws + WS_HB); bf16* ACT = (bf16*)(ws + WS_ACT);

    if (IN(0)) { p0_prologue(F); } SEAM(0);
    float* SS0 = (float*)(ws + WS_SS0); float* SS1 = (float*)(ws + WS_SS1); float* SS2 = (float*)(ws + WS_SS2);
    if (IN(1)) { pg8::Gemm g{HB, (const bf16*)(ws + WS_WGU1), M, NGU, D}; pg8::StaticOrder S; S.init(M, NGU, F.G, (int)blockIdx.x);
        pg8::EpiGU E{ACT, SS0}; pg8::gemm_phase<pg8::EpiGU, pg8::StaticOrder, PG8_ALIGN, PG8_SP2>(F.lds, g, S, E); } SEAM(1);
    if (IN(2)) { pg8::Gemm g{ACT, (const bf16*)(ws + WS_WDN1), M, D, FF}; pg8::StaticOrder S; S.init(M, D, F.G, (int)blockIdx.x); S.rev = true;
        pg8::EpiRes<false, true> E{HB, nullptr, SS1}; pg8::gemm_phase<pg8::EpiRes<false, true>, pg8::StaticOrder, PG8_ALIGN, PG8_SP2>(F.lds, g, S, E); } SEAM(2);
    if (IN(3)) { pg8::Gemm g{HB, (const bf16*)(ws + WS_WIN), M, NIN, D}; pg8::StaticOrder S; S.init(M, NIN, F.G, (int)blockIdx.x);
        pg8::EpiIn E{(bf16*)(ws + WS_XR), (bf16*)(ws + WS_GL), (bf16*)(ws + WS_Q), (bf16*)(ws + WS_K), (bf16*)(ws + WS_V), (bf16*)(ws + WS_GB), F.in[11], F.in[12], SS1};
        pg8::gemm_phase<pg8::EpiIn, pg8::StaticOrder, PG8_ALIGN, PG8_SP2>(F.lds, g, S, E); } SEAM(3);
    if (IN(4)) { scan_phase(F); } SEAM(4);
    if (IN(5)) { attn_phase(F); } SEAM(5);
    if (IN(6)) { pg8::Gemm g{(const bf16*)(ws + WS_GL), (const bf16*)(ws + WS_WOUT), M, D, D}; pg8::StaticOrder S; S.init(M, D, F.G, (int)blockIdx.x);
        pg8::EpiRes<false, false> E{HB, nullptr, SS2}; pg8::gemm_phase<pg8::EpiRes<false, false>, pg8::StaticOrder, PG8_ALIGN, PG8_SP2>(F.lds, g, S, E); } SEAM(6);
    if (IN(7)) { pg8::Gemm g{HB, (const bf16*)(ws + WS_WGU2), M, NGU, D}; pg8::StaticOrder S; S.init(M, NGU, F.G, (int)blockIdx.x);
        pg8::EpiGU E{ACT, SS2}; pg8::gemm_phase<pg8::EpiGU, pg8::StaticOrder, PG8_ALIGN, PG8_SP2>(F.lds, g, S, E); } SEAM(7);
    if (IN(8)) { pg8::Gemm g{ACT, (const bf16*)(ws + WS_WDN2), M, D, FF}; pg8::StaticOrder S; S.init(M, D, F.G, (int)blockIdx.x); S.rev = true;
        pg8::EpiRes<true, true> E{HB, F.out, nullptr}; pg8::gemm_phase<pg8::EpiRes<true, true>, pg8::StaticOrder, PG8_ALIGN, PG8_SP2>(F.lds, g, S, E); }
#undef IN
#undef SEAM
}

extern "C" void kernel_launch(void* const* d_in, const int* in_sizes, int n_in, void* d_out, int out_size, void* d_ws, size_t ws_size, hipStream_t stream) {
    static int grid = 0;
    if (grid == 0) {
        if (n_in != 18 || in_sizes[0] != M * D || out_size != M * D || ws_size < WS_END) { fprintf(stderr, "kernel_launch: shape/workspace mismatch (n_in %d, in0 %d, out %d, ws %zu, need %zu)\n", n_in, n_in > 0 ? in_sizes[0] : -1, out_size, ws_size, (size_t)WS_END); grid = -1; return; }
        int dev = 0, cus = 0, per_cu = 0;
        if (hipGetDevice(&dev) != hipSuccess || hipDeviceGetAttribute(&cus, hipDeviceAttributeMultiprocessorCount, dev) != hipSuccess) { grid = -1; return; }
        if (hipFuncSetAttribute((const void*)mk_fwd, hipFuncAttributeMaxDynamicSharedMemorySize, LDS_BYTES) != hipSuccess) { fprintf(stderr, "kernel_launch: hipFuncSetAttribute failed\n"); grid = -1; return; }
        if (hipOccupancyMaxActiveBlocksPerMultiprocessor(&per_cu, (const void*)mk_fwd, NWAVES * 64, LDS_BYTES) != hipSuccess || per_cu < 1) { fprintf(stderr, "kernel_launch: occupancy query says %d blocks per CU\n", per_cu); per_cu = 1; }
        (void)hipGetLastError();
        grid = cus * 1;
    }
    if (grid < 0) return;
    Args a{};
    for (int i = 0; i < 18; ++i) a.in[i] = (const float*)d_in[i];
    a.out = (float*)d_out; a.ws = (unsigned char*)d_ws;
#if MK_MULTI
    for (int p = 0; p < N_PHASES; ++p) { a.ph_lo = p; a.ph_hi = p + 1; a.coop = 0; hipLaunchKernelGGL(mk_fwd, dim3(grid), dim3(NWAVES * 64), LDS_BYTES, stream, a); }
#else
    a.ph_lo = 0; a.ph_hi = N_PHASES; a.coop = 1;
    void* kargs[] = {&a};
    hipError_t e = hipLaunchCooperativeKernel((const void*)mk_fwd, dim3(grid), dim3(NWAVES * 64), kargs, LDS_BYTES, stream);
    if (e != hipSuccess) fprintf(stderr, "kernel_launch: cooperative launch failed: %s (grid %d)\n", hipGetErrorString(e), grid);
#endif
}
```
